# Optimizing an MI355X kernel written in HIP

```python
import math
import jax, jax.numpy as jnp
from jax import lax
import numpy as np

D_MODEL = 1024
BATCH = 16
SEQ = 2048
DEPTH = 1

N_DIFF_HEADS = 8
DIFF_HEAD_DIM = 64
DIFF_V_DIM = 2 * DIFF_HEAD_DIM
D_ATTN_QK = N_DIFF_HEADS * 2 * DIFF_HEAD_DIM
D_ATTN_V = N_DIFF_HEADS * DIFF_V_DIM
Q_BLOCK = 128
N_BUCKETS = 32
MAX_EXACT = 16
MAX_DISTANCE = 128
POOL_WINDOWS = (2, 4, 8, 16)
N_POOL_GROUPS = len(POOL_WINDOWS)
D_POOL = D_MODEL
POOL_GROUP_DIM = D_POOL // N_POOL_GROUPS
D_IN = 2 * D_ATTN_QK + D_ATTN_V + D_POOL + 2 * D_MODEL
SPLIT_POINTS = (D_ATTN_QK, 2 * D_ATTN_QK, 2 * D_ATTN_QK + D_ATTN_V,
                2 * D_ATTN_QK + D_ATTN_V + D_POOL,
                2 * D_ATTN_QK + D_ATTN_V + D_POOL + D_MODEL)
N_RET_HEADS = 8
N_KEYS = 128
N_EXPERTS = N_KEYS * N_KEYS
D_QUERY = 256
D_SUBKEY = D_QUERY // 2
TOPK = 16
TOKEN_CHUNK = 128

NORM_EPS = 1e-6
SUBLN_EPS = 1e-5
NEG_INF = -1e30

kernel_name = 'hybrid_diffattn_pool_peer_adaln'


def rms_norm(x, w, eps=NORM_EPS):
    xf = x.astype(jnp.float32)
    y = xf * lax.rsqrt(jnp.mean(xf * xf, axis=-1, keepdims=True) + eps)
    return (y * w.astype(jnp.float32)).astype(x.dtype)


def modulate(h, shift, scale):
    return h * (1 + scale[:, None, :]) + shift[:, None, :]


def t5_bucket(dist):
    d = jnp.maximum(dist, 0)
    large = MAX_EXACT + (jnp.log(jnp.maximum(d, 1).astype(jnp.float32) / MAX_EXACT)
                         / math.log(MAX_DISTANCE / MAX_EXACT)
                         * (N_BUCKETS - MAX_EXACT)).astype(jnp.int32)
    large = jnp.minimum(large, N_BUCKETS - 1)
    return jnp.where(d < MAX_EXACT, d, large)


def diff_attention(q, k, v, lam, lam_init, subln_w, rel_bias):
    B, S = q.shape[0], q.shape[1]
    q = q.transpose(0, 2, 3, 1, 4)
    k = k.transpose(0, 2, 3, 1, 4)
    q1, q2 = q[:, :, 0], q[:, :, 1]
    k1, k2 = k[:, :, 0], k[:, :, 1]
    v = v.transpose(0, 2, 1, 3)
    scale = DIFF_HEAD_DIM ** -0.5
    outs = []
    for i in range(S // Q_BLOCK):
        lo, hi = i * Q_BLOCK, (i + 1) * Q_BLOCK
        dist = jnp.arange(lo, hi)[:, None] - jnp.arange(hi)[None, :]
        bias = rel_bias[t5_bucket(dist)].astype(jnp.float32).transpose(2, 0, 1)
        causal = dist >= 0

        def probs(qm, km):
            s = jnp.einsum('bhqd,bhkd->bhqk', qm[:, :, lo:hi].astype(jnp.float32),
                           km[:, :, :hi].astype(jnp.float32)) * scale + bias
            s = jnp.where(causal, s, NEG_INF)
            return jax.nn.softmax(s, axis=-1)

        a = probs(q1, k1) - lam * probs(q2, k2)
        outs.append(jnp.einsum('bhqk,bhkv->bhqv', a.astype(v.dtype), v[:, :, :hi]))
    o = jnp.concatenate(outs, axis=2)
    o = rms_norm(o, subln_w, SUBLN_EPS) * (1.0 - lam_init)
    return o.transpose(0, 2, 1, 3).reshape(B, S, N_DIFF_HEADS * DIFF_V_DIM)


def multiscale_pool(p, pool_w, pool_scale):
    B, S, _ = p.shape
    pf = p.astype(jnp.float32)
    cs = jnp.cumsum(pf, axis=1)
    t = jnp.arange(S)
    groups = []
    for g, w in enumerate(POOL_WINDOWS):
        ch = slice(g * POOL_GROUP_DIM, (g + 1) * POOL_GROUP_DIM)
        upper = cs[:, :, ch]
        lower = jnp.pad(cs[:, :S - w, ch], ((0, 0), (w, 0), (0, 0)))
        count = jnp.minimum(t + 1, w).astype(jnp.float32)[None, :, None]
        groups.append((upper - lower) / count - pf[:, :, ch])
    pooled = jnp.stack(groups, axis=2).astype(p.dtype)
    y = jnp.einsum('bsgc,gce->bsge', pooled, pool_w).reshape(B, S, D_POOL)
    return y * pool_scale


def peer(h, w_query, sub_keys_1, sub_keys_2, expert_down, expert_up):
    B, S, D = h.shape
    xs = h.reshape(-1, TOKEN_CHUNK, D)

    def chunk(xc):
        T = xc.shape[0]
        q = (xc @ w_query).reshape(T, N_RET_HEADS, 2, D_SUBKEY).astype(jnp.float32)
        s1 = jnp.einsum('thd,hnd->thn', q[:, :, 0], sub_keys_1.astype(jnp.float32))
        s2 = jnp.einsum('thd,hnd->thn', q[:, :, 1], sub_keys_2.astype(jnp.float32))
        v1, i1 = lax.top_k(s1, TOPK)
        v2, i2 = lax.top_k(s2, TOPK)
        cand = (v1[..., :, None] + v2[..., None, :]).reshape(T, N_RET_HEADS, TOPK * TOPK)
        cidx = (i1[..., :, None] * N_KEYS + i2[..., None, :]).reshape(T, N_RET_HEADS, TOPK * TOPK)
        sc, pos = lax.top_k(cand, TOPK)
        eidx = jnp.take_along_axis(cidx, pos, axis=-1)
        gate = jax.nn.softmax(sc, axis=-1)
        u = expert_down[eidx]
        act = jax.nn.gelu(jnp.einsum('td,thkd->thk', xc, u).astype(jnp.float32), approximate=False)
        wgt = (gate * act).astype(xc.dtype)
        return jnp.einsum('thk,thkd->td', wgt, expert_up[eidx])

    return lax.map(chunk, xs).reshape(B, S, D)


def setup_inputs(seed: int = 0) -> dict:
    key = jax.random.key(seed)
    ks = jax.random.split(key, 22)
    f32 = jnp.float32
    D, L = D_MODEL, DEPTH

    def nrm(k, shape, s):
        return jax.random.normal(k, shape, f32) * s

    def gain(k, shape):
        return 1.0 + 0.02 * jax.random.normal(k, shape, f32)

    return {
        'x': nrm(ks[0], (BATCH, SEQ, D), 1.0),
        'c': nrm(ks[1], (BATCH, D), 1.0),
        'w_ada': nrm(ks[2], (L, D, 6 * D), 0.5 * D ** -0.5),
        'b_ada': nrm(ks[3], (L, 6 * D), 0.02),
        'norm_mix_w': gain(ks[4], (L, D)),
        'w_in': nrm(ks[5], (L, D, D_IN), D ** -0.5),
        'lambda_q1': nrm(ks[6], (L, DIFF_HEAD_DIM), 0.1),
        'lambda_k1': nrm(ks[7], (L, DIFF_HEAD_DIM), 0.1),
        'lambda_q2': nrm(ks[8], (L, DIFF_HEAD_DIM), 0.1),
        'lambda_k2': nrm(ks[9], (L, DIFF_HEAD_DIM), 0.1),
        'subln_w': gain(ks[10], (L, DIFF_V_DIM)),
        'rel_bias': nrm(ks[11], (N_BUCKETS, N_DIFF_HEADS), 0.5),
        'pool_w': nrm(ks[12], (L, N_POOL_GROUPS, POOL_GROUP_DIM, POOL_GROUP_DIM), POOL_GROUP_DIM ** -0.5),
        'pool_scale': gain(ks[13], (L, D_POOL)),
        'w_out': nrm(ks[14], (L, D, D), D ** -0.5),
        'norm_ffn_w': gain(ks[15], (L, D)),
        'w_query': nrm(ks[16], (L, D, N_RET_HEADS * D_QUERY), D ** -0.5),
        'sub_keys_1': nrm(ks[17], (L, N_RET_HEADS, N_KEYS, D_SUBKEY), D_SUBKEY ** -0.5),
        'sub_keys_2': nrm(ks[18], (L, N_RET_HEADS, N_KEYS, D_SUBKEY), D_SUBKEY ** -0.5),
        'expert_down': nrm(ks[19], (L, N_EXPERTS, D), D ** -0.5),
        'expert_up': nrm(ks[20], (L, N_EXPERTS, D), N_RET_HEADS ** -0.5),
        'norm_final_w': gain(ks[21], (D,)),
    }


def reference(x, c, w_ada, b_ada, norm_mix_w, w_in, lambda_q1, lambda_k1, lambda_q2, lambda_k2,
              subln_w, rel_bias, pool_w, pool_scale, w_out, norm_ffn_w, w_query,
              sub_keys_1, sub_keys_2, expert_down, expert_up, norm_final_w):
    B, S, _ = x.shape
    c_act = jax.nn.silu(c)
    for l in range(DEPTH):
        lam_init = 0.8 - 0.6 * math.exp(-0.3 * l)
        mod = c_act @ w_ada[l] + b_ada[l]
        sh1, sc1, g1, sh2, sc2, g2 = jnp.split(mod, 6, axis=-1)

        h = modulate(rms_norm(x, norm_mix_w[l]), sh1, sc1)
        proj = h @ w_in[l]
        q, k, v, p, g_attn, g_pool = jnp.split(proj, SPLIT_POINTS, axis=-1)
        lam = (jnp.exp(jnp.sum(lambda_q1[l].astype(jnp.float32) * lambda_k1[l].astype(jnp.float32)))
               - jnp.exp(jnp.sum(lambda_q2[l].astype(jnp.float32) * lambda_k2[l].astype(jnp.float32)))
               + lam_init)
        attn = diff_attention(q.reshape(B, S, N_DIFF_HEADS, 2, DIFF_HEAD_DIM),
                              k.reshape(B, S, N_DIFF_HEADS, 2, DIFF_HEAD_DIM),
                              v.reshape(B, S, N_DIFF_HEADS, DIFF_V_DIM),
                              lam, lam_init, subln_w[l], rel_bias)
        pool = multiscale_pool(p, pool_w[l], pool_scale[l])
        merged = jax.nn.sigmoid(g_attn) * attn + jax.nn.sigmoid(g_pool) * pool
        x = x + g1[:, None, :] * (merged @ w_out[l])

        h = modulate(rms_norm(x, norm_ffn_w[l]), sh2, sc2)
        x = x + g2[:, None, :] * peer(h, w_query[l], sub_keys_1[l], sub_keys_2[l],
                                      expert_down[l], expert_up[l])
    return rms_norm(x, norm_final_w)
```

```cpp
#include <hip/hip_runtime.h>
#include <cstdio>
#include <cstdint>
namespace pg8 {
#define PG8_LAS __attribute__((address_space(3)))
typedef unsigned short bf16_t;
typedef short bf16x8 __attribute__((ext_vector_type(8)));
typedef float f32x4 __attribute__((ext_vector_type(4)));
typedef unsigned u32x4 __attribute__((ext_vector_type(4)));
constexpr int BM = 256, BK = 64, HALF = 128, HTB = HALF * BK * 2  , STAGE_BYTES = 8 * HTB, NXCD = 8, WGM = 8;

__host__ __device__ __forceinline__ int lds_byte(int r, int c) { const int st = (r >> 4) * 2 + (c >> 5), rr = r & 15, cc = c & 31, ob = rr * 64 + cc * 2; return st * 1024 + (ob ^ (((ob >> 9) & 1) << 5)); }
__host__ __device__ __forceinline__ void stage_rc(int b, int& R, int& C) { const int st = b / 1024, sb = b % 1024, swz = sb ^ (((sb >> 9) & 1) << 5); R = (st >> 1) * 16 + swz / 64; C = (st & 1) * 32 + (swz % 64) / 2; }
__host__ __device__ __forceinline__ int perm32(int rho) { const int n = rho >> 4, i = rho & 15; return 8 * (i >> 2) + 4 * n + (i & 3); }

struct Unit { int pm, pn; };
struct Gemm { const bf16_t* A; const bf16_t* Bt; int M, N, K, lda, a_pn; };

struct StaticOrder {
    int nM, nN, nwg, G, c;
    __host__ __device__ void init(int M, int N, int G_, int c_) { nM = M / BM; nN = N / BM; nwg = nM * nN; G = G_; c = c_; }
    __host__ __device__ bool next(int i, Unit& u) const {
        const long L = (long)i * G + c; if (L >= nwg) return false;
        int wgid = (int)L; { const int q = nwg / NXCD, r = nwg % NXCD, xcd = wgid % NXCD, off = wgid / NXCD; wgid = (xcd < r ? xcd * (q + 1) : r * (q + 1) + (xcd - r) * q) + off; }
        const int nig = WGM * nN, gid = wgid / nig, fm = gid * WGM, gsz = (nM - fm) < WGM ? (nM - fm) : WGM;
        u.pm = fm + ((wgid % nig) % gsz); u.pn = (wgid % nig) / gsz; return true;
    }
    __device__ __forceinline__ void a_ready(const Unit&) const {}
    __device__ __forceinline__ void done(const Unit&) const {}
};

__device__ __forceinline__ unsigned cvt_pk_bf16(float lo, float hi) { unsigned r; asm volatile("v_cvt_pk_bf16_f32 %0, %1, %2" : "=v"(r) : "v"(lo), "v"(hi)); return r; }
typedef float f32x2 __attribute__((ext_vector_type(2)));
__device__ __forceinline__ f32x2 gelu_pk(f32x2 v) {
    const f32x2 av = __builtin_elementwise_abs(v), d = av * 0.2316418882f + 1.0f;
    f32x2 t; t.x = __builtin_amdgcn_rcpf(d.x); t.y = __builtin_amdgcn_rcpf(d.y);
    f32x2 q = t * 0.5307027145f + (-0.7265760135f); q = q * t + 0.7107068705f; q = q * t + (-0.142248368f); q = q * t + 0.127414796f; q = q * t;
    const f32x2 s = (v * v) * (-0.72134752044f);
    f32x2 e; e.x = __builtin_amdgcn_exp2f(s.x); e.y = __builtin_amdgcn_exp2f(s.y);
    const f32x2 m = v * (q * e), r = v - m;
    f32x2 o; o.x = v.x < 0.f ? m.x : r.x; o.y = v.y < 0.f ? m.y : r.y; return o;
}

template <int ACT  > struct EpiBf16 {
    static constexpr bool PERM = true, AFTER_DRAIN = false; static_assert(ACT == 0 || ACT == 1, "EpiBf16: ACT is 0 (none) or 1 (gelu_pk)");
    bf16_t* O; int ldc; const float* bias; int split_cols; size_t split_stride; float scale0;
    __device__ __forceinline__ void operator()(const f32x4 (&acc)[2][2][4][2], const Unit& u, int wr, int wc, int fr, int fq) const {
        const int row0 = u.pm * BM + wr * 64 + fr; int colt = u.pn * BM; bf16_t* base = O;
        float sc = 1.f; if (split_cols) { const int t = colt / split_cols; base += (size_t)t * split_stride; colt -= t * split_cols; if (t == 0) sc = scale0; }
        const int col0 = colt + wc * 32 + 8 * fq, bcol0 = u.pn * BM + wc * 32 + 8 * fq;
        f32x4 bv[2][2];
#pragma unroll
        for (int bj = 0; bj < 2; ++bj)
#pragma unroll
            for (int n = 0; n < 2; ++n) bv[bj][n] = bias ? *(const f32x4*)(bias + bcol0 + bj * HALF + 4 * n) : (f32x4){0.f, 0.f, 0.f, 0.f};
#pragma unroll
        for (int ai = 0; ai < 2; ++ai)
#pragma unroll
            for (int m = 0; m < 4; ++m) { bf16_t* rowp = base + (size_t)(row0 + ai * HALF + m * 16) * ldc + col0;
#pragma unroll
                for (int bj = 0; bj < 2; ++bj) { f32x4 v0 = acc[ai][bj][m][0] + bv[bj][0], v1 = acc[ai][bj][m][1] + bv[bj][1];
                    if (ACT == 1) { f32x2 a = gelu_pk((f32x2){v0[0], v0[1]}), b = gelu_pk((f32x2){v0[2], v0[3]}), c = gelu_pk((f32x2){v1[0], v1[1]}), d = gelu_pk((f32x2){v1[2], v1[3]});
                        v0 = (f32x4){a.x, a.y, b.x, b.y}; v1 = (f32x4){c.x, c.y, d.x, d.y}; }
                    v0 = v0 * sc; v1 = v1 * sc; u32x4 w; w.x = cvt_pk_bf16(v0[0], v0[1]); w.y = cvt_pk_bf16(v0[2], v0[3]); w.z = cvt_pk_bf16(v1[0], v1[1]); w.w = cvt_pk_bf16(v1[2], v1[3]);
                    *(u32x4*)(rowp + bj * HALF) = w; } }
    }
};
__device__ __forceinline__ float bf_lo(unsigned w) { return __builtin_bit_cast(float, w << 16); }
__device__ __forceinline__ float bf_hi(unsigned w) { return __builtin_bit_cast(float, w & 0xffff0000u); }
__device__ __forceinline__ float sigmoidf_(float x) { return __builtin_amdgcn_rcpf(1.0f + __builtin_amdgcn_exp2f(-1.4426950408889634f * x)); }
struct EpiPool {
    static constexpr bool PERM = true, AFTER_DRAIN = false;
    bf16_t* MG; const bf16_t* GP; int ldc;
    __device__ __forceinline__ void operator()(const f32x4 (&acc)[2][2][4][2], const Unit& u, int wr, int wc, int fr, int fq) const {
        const int row0 = u.pm * BM + wr * 64 + fr, col0 = u.pn * BM + wc * 32 + 8 * fq;
#pragma unroll
        for (int ai = 0; ai < 2; ++ai)
#pragma unroll
            for (int m = 0; m < 4; ++m) { const size_t ro = (size_t)(row0 + ai * HALF + m * 16) * ldc + col0;
#pragma unroll
                for (int bj = 0; bj < 2; ++bj) {
                    const u32x4 mg = *(const u32x4*)(MG + ro + bj * HALF), gp = *(const u32x4*)(GP + ro + bj * HALF);
                    const f32x4 a0 = acc[ai][bj][m][0], a1 = acc[ai][bj][m][1];
                    u32x4 w;
                    w.x = cvt_pk_bf16(bf_lo(mg.x) + a0[0] * sigmoidf_(bf_lo(gp.x)), bf_hi(mg.x) + a0[1] * sigmoidf_(bf_hi(gp.x)));
                    w.y = cvt_pk_bf16(bf_lo(mg.y) + a0[2] * sigmoidf_(bf_lo(gp.y)), bf_hi(mg.y) + a0[3] * sigmoidf_(bf_hi(gp.y)));
                    w.z = cvt_pk_bf16(bf_lo(mg.z) + a1[0] * sigmoidf_(bf_lo(gp.z)), bf_hi(mg.z) + a1[1] * sigmoidf_(bf_hi(gp.z)));
                    w.w = cvt_pk_bf16(bf_lo(mg.w) + a1[2] * sigmoidf_(bf_lo(gp.w)), bf_hi(mg.w) + a1[3] * sigmoidf_(bf_hi(gp.w)));
                    *(u32x4*)(MG + ro + bj * HALF) = w; }
                asm volatile("" ::: "memory"); }
    }
};
struct EpiResid {
    static constexpr bool PERM = false, AFTER_DRAIN = false;
    const float* x; float* out; const float* gate; int ldc, gpitch, rows_per_b;
    __device__ __forceinline__ void operator()(const f32x4 (&acc)[2][2][4][2], const Unit& u, int wr, int wc, int fr, int fq) const {
        const int row0 = u.pm * BM + wr * 64 + fr, col0 = u.pn * BM + wc * 32 + 4 * fq;
        const float* gb = gate + (size_t)((u.pm * BM) / rows_per_b) * gpitch + col0;
        f32x4 gv[2][2];
#pragma unroll
        for (int bj = 0; bj < 2; ++bj)
#pragma unroll
            for (int n = 0; n < 2; ++n) gv[bj][n] = *(const f32x4*)(gb + bj * HALF + n * 16);
#pragma unroll
        for (int ai = 0; ai < 2; ++ai)
#pragma unroll
            for (int m = 0; m < 4; ++m) { const size_t ro = (size_t)(row0 + ai * HALF + m * 16) * ldc + col0;
#pragma unroll
                for (int bj = 0; bj < 2; ++bj)
#pragma unroll
                    for (int n = 0; n < 2; ++n) { const size_t off = ro + bj * HALF + n * 16; const f32x4 xv = *(const f32x4*)(x + off);
                        *(f32x4*)(out + off) = xv + gv[bj][n] * acc[ai][bj][m][n]; } }
    }
};
template <class Epi, class Sched, bool ALIGN_EPI = false, bool SP2 = false>
__device__ __forceinline__ void gemm_phase(PG8_LAS unsigned char* lds, const Gemm g, const Sched& S, const Epi& E) {
    const int tid = threadIdx.x, wid = __builtin_amdgcn_readfirstlane(tid >> 6), lane = tid & 63, wr = wid >> 2, wc = wid & 3, fr = lane & 15, fq = lane >> 4;
    int K = g.K; asm volatile("" : "+s"(K));
    const int nt = K / BK;
    unsigned voffA[2], voffB[2];
#pragma unroll
    for (int i = 0; i < 2; ++i) { int R, C; stage_rc(tid * 16 + i * 8192, R, C); const int Rb = Epi::PERM ? ((R & ~31) + perm32(R & 31)) : R;
        voffA[i] = (unsigned)(R * g.lda + C) * 2u; voffB[i] = (unsigned)(Rb * K + C) * 2u; }
    const size_t kstep = (size_t)(BK * 2);
    const size_t hstepA = (size_t)HALF * g.lda * 2, hstepB = (size_t)HALF * K * 2;
    const size_t tstepA = 2 * hstepA, tstepB = 2 * hstepB, pnA = (size_t)g.a_pn * 2;
    const unsigned ldsw = (unsigned)wid * 1024u;
    const int aoff = lds_byte(wr * 64 + fr, fq * 8), boff = lds_byte(wc * 32 + fr, fq * 8);
#define PG8_SA(b, h) (((b) * 2 + (h)) * HTB)
#define PG8_SB(b, h) ((4 + (b) * 2 + (h)) * HTB)
#define PG8_STAGE(bufoff, gbase, voff) do { _Pragma("unroll") for (int _i = 0; _i < 2; ++_i) \
        __builtin_amdgcn_global_load_lds((const unsigned*)((const char*)(gbase) + (voff)[_i]), (PG8_LAS unsigned*)(lds + (bufoff) + ldsw + _i * 8192), 16, 0, 0); } while (0)
#define PG8_LDA(dst, b, h) do { _Pragma("unroll") for (int m = 0; m < 4; ++m) _Pragma("unroll") for (int k = 0; k < 2; ++k) dst[m][k] = *(const PG8_LAS bf16x8*)(lds + PG8_SA(b, h) + aoff + m * 2048 + k * 1024); } while (0)
#define PG8_LDB(dst, b, h) do { _Pragma("unroll") for (int n = 0; n < 2; ++n) _Pragma("unroll") for (int k = 0; k < 2; ++k) dst[n][k] = *(const PG8_LAS bf16x8*)(lds + PG8_SB(b, h) + boff + n * 2048 + k * 1024); } while (0)
#define PG8_MMA(ai, bj, At, Bt) do { __builtin_amdgcn_s_setprio(1); _Pragma("unroll") for (int m = 0; m < 4; ++m) _Pragma("unroll") for (int n = 0; n < 2; ++n) _Pragma("unroll") for (int k = 0; k < 2; ++k) \
        acc[ai][bj][m][n] = __builtin_amdgcn_mfma_f32_16x16x32_bf16(Bt[n][k], At[m][k], acc[ai][bj][m][n], 0, 0, 0); __builtin_amdgcn_s_setprio(0); } while (0)
#define PG8_WAIT_V(n) asm volatile("s_waitcnt vmcnt(" #n ")" ::: "memory")
#define PG8_WAIT_L(n) asm volatile("s_waitcnt lgkmcnt(" #n ")" ::: "memory")
#define PG8_BAR __builtin_amdgcn_s_barrier()
#define PG8_SCHED __builtin_amdgcn_sched_barrier(0)
    Unit cur, nxt; int ui = 0;
    if (!S.next(0, cur)) return;
    f32x4 acc[2][2][4][2];
#pragma unroll
    for (int a = 0; a < 2; ++a)
#pragma unroll
        for (int b = 0; b < 2; ++b)
#pragma unroll
            for (int m = 0; m < 4; ++m)
#pragma unroll
                for (int n = 0; n < 2; ++n) acc[a][b][m][n] = (f32x4){0.f, 0.f, 0.f, 0.f};
    bf16x8 At[4][2], B0[2][2], B1[2][2];
    const char* cA = (const char*)g.A + (size_t)cur.pm * tstepA + (size_t)cur.pn * pnA; const char* cB = (const char*)g.Bt + (size_t)cur.pn * tstepB;
    S.a_ready(cur);
    if constexpr (SP2) {
        PG8_STAGE(PG8_SB(0, 0), cB, voffB); PG8_STAGE(PG8_SB(0, 1), cB + hstepB, voffB); PG8_STAGE(PG8_SA(0, 0), cA, voffA); PG8_STAGE(PG8_SA(0, 1), cA + hstepA, voffA);
        if (wr == 1) PG8_BAR;
        PG8_WAIT_V(2); PG8_BAR;
        PG8_STAGE(PG8_SB(1, 0), cB + kstep, voffB); PG8_STAGE(PG8_SA(1, 0), cA + kstep, voffA); PG8_STAGE(PG8_SB(1, 1), cB + hstepB + kstep, voffB);
        PG8_WAIT_V(6); PG8_BAR;
    } else {
        PG8_STAGE(PG8_SB(0, 0), cB, voffB); PG8_STAGE(PG8_SA(0, 0), cA, voffA); PG8_STAGE(PG8_SB(0, 1), cB + hstepB, voffB); PG8_STAGE(PG8_SA(0, 1), cA + hstepA, voffA);
        if (wr == 1) PG8_BAR;
        PG8_WAIT_V(4); PG8_BAR;
        PG8_STAGE(PG8_SB(1, 0), cB + kstep, voffB); PG8_STAGE(PG8_SA(1, 0), cA + kstep, voffA); PG8_STAGE(PG8_SB(1, 1), cB + hstepB + kstep, voffB);
        PG8_WAIT_V(6); PG8_BAR;
    }
    for (;;) {
        const bool has_next = S.next(ui + 1, nxt);
        const char* nA = has_next ? (const char*)g.A + (size_t)nxt.pm * tstepA + (size_t)nxt.pn * pnA : cA; const char* nB = has_next ? (const char*)g.Bt + (size_t)nxt.pn * tstepB : cB;
        for (int t = 0; t < nt; t += 2) {
            const bool last = (t == nt - 2);
            const char* a1 = cA + (size_t)(t + 1) * kstep;
            const char* a2 = last ? nA : cA + (size_t)(t + 2) * kstep; const char* b2 = last ? nB : cB + (size_t)(t + 2) * kstep;
            const char* a3 = a2 + kstep; const char* b3 = b2 + kstep;
            if (last && has_next) S.a_ready(nxt);
            if constexpr (SP2) {
            PG8_LDB(B0, 0, 0); PG8_LDB(B1, 0, 1); PG8_SCHED; PG8_LDA(At, 0, 0); PG8_STAGE(PG8_SA(1, 1), a1 + hstepA, voffA);
            PG8_WAIT_V(8); PG8_WAIT_L(0); PG8_BAR; PG8_MMA(0, 0, At, B0); PG8_MMA(0, 1, At, B1); PG8_BAR; PG8_SCHED;
            PG8_LDA(At, 0, 1); PG8_STAGE(PG8_SB(0, 0), b2, voffB); PG8_STAGE(PG8_SB(0, 1), b2 + hstepB, voffB); PG8_STAGE(PG8_SA(0, 0), a2, voffA);
            PG8_WAIT_V(8); PG8_WAIT_L(0); PG8_BAR; PG8_MMA(1, 0, At, B0); PG8_MMA(1, 1, At, B1); PG8_BAR; PG8_SCHED;
            PG8_LDB(B0, 1, 0); PG8_LDB(B1, 1, 1); PG8_SCHED; PG8_LDA(At, 1, 0); PG8_STAGE(PG8_SA(0, 1), a2 + hstepA, voffA);
            PG8_WAIT_V(8); PG8_WAIT_L(0); PG8_BAR; PG8_MMA(0, 0, At, B0); PG8_MMA(0, 1, At, B1); PG8_BAR; PG8_SCHED;
            PG8_LDA(At, 1, 1); PG8_STAGE(PG8_SB(1, 0), b3, voffB); PG8_STAGE(PG8_SB(1, 1), b3 + hstepB, voffB); PG8_STAGE(PG8_SA(1, 0), a3, voffA);
            PG8_WAIT_V(8); PG8_WAIT_L(0); PG8_BAR; PG8_MMA(1, 0, At, B0); PG8_MMA(1, 1, At, B1); PG8_BAR; PG8_SCHED;
            } else {
            PG8_LDB(B0, 0, 0); PG8_SCHED; PG8_LDA(At, 0, 0); PG8_STAGE(PG8_SA(1, 1), a1 + hstepA, voffA);
            PG8_WAIT_L(8); PG8_BAR; PG8_WAIT_L(0); PG8_MMA(0, 0, At, B0); PG8_BAR; PG8_SCHED;
            PG8_LDB(B1, 0, 1); PG8_STAGE(PG8_SB(0, 0), b2, voffB);
            PG8_BAR; PG8_WAIT_L(0); PG8_MMA(0, 1, At, B1); PG8_BAR;
            PG8_LDA(At, 0, 1); PG8_STAGE(PG8_SA(0, 0), a2, voffA);
            PG8_BAR; PG8_WAIT_L(0); PG8_MMA(1, 0, At, B0); PG8_BAR; PG8_SCHED;
            PG8_STAGE(PG8_SB(0, 1), b2 + hstepB, voffB);
            PG8_WAIT_V(6); PG8_BAR; PG8_MMA(1, 1, At, B1); PG8_BAR;
            PG8_LDB(B0, 1, 0); PG8_SCHED; PG8_LDA(At, 1, 0); PG8_STAGE(PG8_SA(0, 1), a2 + hstepA, voffA);
            PG8_WAIT_L(8); PG8_BAR; PG8_WAIT_L(0); PG8_MMA(0, 0, At, B0); PG8_BAR; PG8_SCHED;
            PG8_LDB(B1, 1, 1); PG8_STAGE(PG8_SB(1, 0), b3, voffB);
            PG8_BAR; PG8_WAIT_L(0); PG8_MMA(0, 1, At, B1); PG8_BAR;
            PG8_LDA(At, 1, 1); PG8_STAGE(PG8_SA(1, 0), a3, voffA);
            PG8_BAR; PG8_WAIT_L(0); PG8_MMA(1, 0, At, B0); PG8_BAR; PG8_SCHED;
            PG8_STAGE(PG8_SB(1, 1), b3 + hstepB, voffB);
            PG8_WAIT_V(6); PG8_BAR; PG8_MMA(1, 1, At, B1); PG8_BAR;
            }
        }
        if constexpr (ALIGN_EPI) { if (wr == 0) PG8_BAR; }
        if constexpr (!Epi::AFTER_DRAIN) { E(acc, cur, wr, wc, fr, fq); S.done(cur); }
        if (!has_next) break;
#pragma unroll
        for (int a = 0; a < 2; ++a)
#pragma unroll
            for (int b = 0; b < 2; ++b)
#pragma unroll
                for (int m = 0; m < 4; ++m)
#pragma unroll
                    for (int n = 0; n < 2; ++n) acc[a][b][m][n] = (f32x4){0.f, 0.f, 0.f, 0.f};
        cur = nxt; cA = nA; cB = nB; ++ui;
        if constexpr (ALIGN_EPI) { if (wr == 1) PG8_BAR; }
    }
    PG8_WAIT_V(0);
    if constexpr (!ALIGN_EPI) { if (wr == 0) PG8_BAR; }
    PG8_BAR;
    if constexpr (Epi::AFTER_DRAIN) { E.fused(acc, cur, wr, wc, fr, fq, lds, wid, lane); S.done(cur); }
#undef PG8_SA
#undef PG8_SB
#undef PG8_STAGE
#undef PG8_LDA
#undef PG8_LDB
#undef PG8_MMA
#undef PG8_WAIT_V
#undef PG8_WAIT_L
#undef PG8_BAR
#undef PG8_SCHED
}
}
#define GAS __attribute__((address_space(1)))
#define LAS __attribute__((address_space(3)))
typedef unsigned short bf16;
typedef unsigned v4u __attribute__((ext_vector_type(4)));
typedef float f32x4 __attribute__((ext_vector_type(4)));
typedef short bf16x8 __attribute__((ext_vector_type(8)));
typedef GAS unsigned gu32;
typedef GAS unsigned long long gu64;
#define RLX_AGENT __ATOMIC_RELAXED, __HIP_MEMORY_SCOPE_AGENT
#define LDS_WAIT() asm volatile("s_waitcnt lgkmcnt(0)" ::: "memory")
#define VM_WAIT() asm volatile("s_waitcnt vmcnt(0)" ::: "memory")
__device__ __forceinline__ unsigned long long rt() { return __builtin_amdgcn_s_memrealtime(); }
__device__ __forceinline__ unsigned f2bf(float f) { unsigned u = __builtin_bit_cast(unsigned, f); return (u + 0x7fffu + ((u >> 16) & 1u)) >> 16; }
__device__ __forceinline__ unsigned pk2(float lo, float hi) { return f2bf(lo) | (f2bf(hi) << 16); }

#define XB_TMO      128
#define XB_XCNT(j)  (256  + 64 * (j))
#define XB_XSUB(j)  (1280 + 64 * (j))
#define XB_XGEN(j)  (2304 + 64 * (j))
#define XB_TOP      3328
#define XB_TOPGEN   3392
#define XCD_BAR_WORDS 3456
#define XB_SPIN_CAP (1u << 18)

__device__ __forceinline__ unsigned xb_ld(unsigned* p)              { return __hip_atomic_load(p, __ATOMIC_RELAXED, __HIP_MEMORY_SCOPE_AGENT); }
__device__ __forceinline__ unsigned xb_add(unsigned* p, unsigned v) { return __hip_atomic_fetch_add(p, v, __ATOMIC_RELAXED, __HIP_MEMORY_SCOPE_AGENT); }
__device__ __forceinline__ unsigned xb_xcc_id() { return (unsigned)__builtin_amdgcn_s_getreg((3 << 11) | 20) & 0xFu; }
#define XB_SPIN(cond, bar) do { unsigned _sp = 0; while (cond) { __builtin_amdgcn_s_sleep(1); \
    if ((++_sp & 255u) == 0u) { if (xb_ld(&(bar)[XB_TMO])) break; if (_sp > XB_SPIN_CAP) { atomicAdd(&(bar)[XB_TMO], 1u); break; } } } } while (0)

struct XcdBarrier {
    unsigned* bar; unsigned x;
    volatile LAS unsigned* st;
};

__device__ __forceinline__ XcdBarrier xcd_barrier_post(unsigned* bar, volatile LAS unsigned* st) {
    XcdBarrier b; b.bar = bar; b.x = xb_xcc_id(); b.st = st;
    if (threadIdx.x == 0) (void)xb_add(&bar[XB_XCNT(b.x)], 1u);
    return b;
}
__device__ __forceinline__ void xcd_barrier_complete(unsigned* bar, unsigned x, unsigned& nloc, unsigned& nx) {
    const unsigned G = gridDim.x * gridDim.y * gridDim.z;
    unsigned sum, cnt, mine, sp = 0u;
    for (;;) {
        sum = 0u; cnt = 0u; mine = 0u;
#pragma unroll
        for (unsigned j = 0; j < 16; ++j) { const unsigned c = xb_ld(&bar[XB_XCNT(j)]); sum += c; cnt += (c > 0u) ? 1u : 0u; mine = (j == x) ? c : mine; }
        if (sum == G) break;
        __builtin_amdgcn_s_sleep(1);
        if ((++sp & 255u) == 0u) { if (xb_ld(&bar[XB_TMO])) break; if (sp > XB_SPIN_CAP) { atomicAdd(&bar[XB_TMO], 1u); break; } }
    }
    nloc = mine > 0u ? mine : 1u; nx = cnt > 0u ? cnt : 1u;
}

__device__ __forceinline__ void xcd_barrier(const XcdBarrier& b) {
    asm volatile("s_waitcnt vmcnt(0)" ::: "memory");
    __syncthreads();
    if (threadIdx.x == 0) {
        unsigned* bar = b.bar;
        __builtin_amdgcn_s_waitcnt(0);
        unsigned nloc = b.st[0], nx = b.st[1];
        if (nloc == 0u) { xcd_barrier_complete(bar, b.x, nloc, nx); b.st[0] = nloc; b.st[1] = nx; }
        const unsigned old = xb_add(&bar[XB_XSUB(b.x)], 1u);
        const unsigned gen = old / nloc;
        if (old + 1u == (gen + 1u) * nloc) {
            __builtin_amdgcn_fence(__ATOMIC_RELEASE, "agent");
            asm volatile("s_waitcnt vmcnt(0)" ::: "memory");
            const unsigned og = xb_add(&bar[XB_TOP], 1u);
            const unsigned tg = og / nx;
            if (og + 1u == (tg + 1u) * nx) xb_add(&bar[XB_TOPGEN], 1u);
            else XB_SPIN(xb_ld(&bar[XB_TOPGEN]) == tg, bar);
            __builtin_amdgcn_fence(__ATOMIC_ACQUIRE, "agent");
            xb_add(&bar[XB_XGEN(b.x)], 1u);
            asm volatile("s_waitcnt vmcnt(0)" ::: "memory");
        } else {
            XB_SPIN(xb_ld(&bar[XB_XGEN(b.x)]) == gen, bar);
            __builtin_amdgcn_fence(__ATOMIC_ACQUIRE, "agent");
            asm volatile("s_waitcnt vmcnt(0)" ::: "memory");
        }
    }
    __syncthreads();
}

constexpr int NWAVES = 8;
constexpr int BATCH = 16, SEQ = 2048, D = 1024, M = BATCH * SEQ, DIN = 6144, DQ2 = 2048, NSEL = 128;
constexpr float C2 = 0.125f * 1.4426950408889634f;
constexpr float LOG2E = 1.4426950408889634f;
constexpr size_t MiB = 1u << 20;
constexpr size_t WS_CTL = 0, CTL_ZERO_BYTES = 1 * MiB;
constexpr size_t WS_MOD = 512 * 1024;
constexpr size_t WS_WIN = 1 * MiB, WS_WOUT = 13 * MiB, WS_WQ = 15 * MiB, WS_WPOOL = 19 * MiB, WS_KEYS = 19 * MiB + 512 * 1024;
constexpr size_t WS_SELI = 20 * MiB, WS_SELG = 36 * MiB;
constexpr size_t WS_XN = 52 * MiB;
constexpr size_t WS_Q = 116 * MiB, WS_K = 180 * MiB, WS_V = 244 * MiB, WS_P = 308 * MiB, WS_GA = 372 * MiB, WS_GP = 436 * MiB, WS_END = 500 * MiB;
constexpr size_t WS_MG = WS_Q;
constexpr size_t WS_Q2 = WS_K;
constexpr int CW_BAR = 4096;
constexpr int RING_BYTES = 131072, LDSCTL_OFF = RING_BYTES, MISC_OFF = LDSCTL_OFF + 320, LDS_BYTES = 147456;

struct Frame {
    LAS unsigned char* lds; volatile LAS unsigned* MISC; gu32* ctl;
    int tid, lane, wave, vcu, G;
    const float* in[22]; float* out; unsigned char* ws;
};
__device__ __forceinline__ float wave_sum(float v) {
#pragma unroll
    for (int o = 1; o < 64; o <<= 1) v += __shfl_xor(v, o);
    return v;
}
__device__ __forceinline__ float bflo(unsigned w) { return __builtin_bit_cast(float, w << 16); }
__device__ __forceinline__ float bfhi(unsigned w) { return __builtin_bit_cast(float, w & 0xffff0000u); }
__device__ __forceinline__ float sigm(float x) { return 1.0f / (1.0f + __expf(-x)); }

__device__ __forceinline__ void p0_transpose_item(const float* W, int K, int N, bf16* WT, int row_off, LAS float* scr, int item, int lane, const float* colscale = nullptr) {
    const int nblk = N / 32, kb = item / nblk, nb = item % nblk, k0 = 64 * kb, n0 = 32 * nb;
    const float cs = colscale ? colscale[n0 + (lane & 31)] : 1.0f;
#pragma unroll 8
    for (int i = 0; i < 32; ++i) { const int kk = 2 * i + (lane >> 5); scr[kk * 33 + (lane & 31)] = W[(size_t)(k0 + kk) * N + n0 + (lane & 31)] * cs; }
    LDS_WAIT(); asm volatile("" ::: "memory");
    const int c = lane & 7;
#pragma unroll
    for (int j = 0; j < 4; ++j) { const int n = (lane >> 3) + 8 * j; const LAS float* s = scr + (8 * c) * 33 + n;
        v4u o; o.x = pk2(s[0 * 33], s[1 * 33]); o.y = pk2(s[2 * 33], s[3 * 33]); o.z = pk2(s[4 * 33], s[5 * 33]); o.w = pk2(s[6 * 33], s[7 * 33]);
        *(GAS v4u*)(WT + (size_t)(row_off + n0 + n) * K + k0 + 8 * c) = o; }
    LDS_WAIT(); asm volatile("" ::: "memory");
}
__device__ __forceinline__ void p0_mod_item(Frame& F, int id) {
    const int cb = id % 96, kc = id / 96, n = cb * 64 + F.lane;
    const float* c = F.in[1]; const float* wada = F.in[2]; const float* bada = F.in[3];
    float acc[16];
#pragma unroll
    for (int b = 0; b < 16; ++b) acc[b] = 0.f;
    for (int k = kc * 128; k < kc * 128 + 128; ++k) {
        const float w = wada[(size_t)k * DIN + n];
#pragma unroll
        for (int b = 0; b < 16; ++b) { const float cv = c[b * D + k]; acc[b] += (cv / (1.0f + __expf(-cv))) * w; }
    }
    float* mod = (float*)(F.ws + WS_MOD);
    const float bb = (kc == 0) ? bada[n] : 0.f;
#pragma unroll
    for (int b = 0; b < 16; ++b) atomicAdd(mod + b * DIN + n, acc[b] + bb);
}
__device__ __forceinline__ void p0a_prologue(Frame& F) {
    LAS float* scr = (LAS float*)(F.lds + F.wave * 16384);
    const int gw = F.vcu * NWAVES + F.wave, NGW = F.G * NWAVES;
    constexpr int I_MOD = 768, I_IN = (D / 64) * (DIN / 32), I_OUT = (D / 64) * (D / 32), I_WQ = (D / 64) * (DQ2 / 32), I_PW = (256 / 64) * (256 / 32), I_KEYS = 2 * 131072 / 512;
    constexpr int NITEMS = I_MOD + I_IN + I_OUT + I_WQ + 4 * I_PW + I_KEYS;
    for (int it = gw; it < NITEMS; it += NGW) {
        int r = it;
        if (r < I_MOD) { p0_mod_item(F, r); continue; } r -= I_MOD;
        if (r < I_IN) { p0_transpose_item(F.in[5], D, DIN, (bf16*)(F.ws + WS_WIN), 0, scr, r, F.lane); continue; } r -= I_IN;
        if (r < I_OUT) { p0_transpose_item(F.in[14], D, D, (bf16*)(F.ws + WS_WOUT), 0, scr, r, F.lane); continue; } r -= I_OUT;
        if (r < I_WQ) { p0_transpose_item(F.in[16], D, DQ2, (bf16*)(F.ws + WS_WQ), 0, scr, r, F.lane); continue; } r -= I_WQ;
        if (r < 4 * I_PW) { const int g = r / I_PW; p0_transpose_item(F.in[12] + (size_t)g * 65536, 256, 256, (bf16*)(F.ws + WS_WPOOL) + (size_t)g * 65536, 0, scr, r % I_PW, F.lane, F.in[13] + g * 256); continue; } r -= 4 * I_PW;
        { const int e0 = r * 512 + F.lane * 8; const float* src = (e0 < 131072) ? (F.in[17] + e0) : (F.in[18] + (e0 - 131072));
          const f32x4 a = *(const f32x4*)src, b = *(const f32x4*)(src + 4);
          v4u o; o.x = pk2(a[0], a[1]); o.y = pk2(a[2], a[3]); o.z = pk2(b[0], b[1]); o.w = pk2(b[2], b[3]);
          *(GAS v4u*)((bf16*)(F.ws + WS_KEYS) + e0) = o; }
    }
}
__device__ __forceinline__ void norm_mod_rows(Frame& F, const float* src, const float* nw, int sh_off, int sc_off, bf16* dst, float eps) {
    const int gw = F.vcu * NWAVES + F.wave, NGW = F.G * NWAVES;
    const float* mod = (const float*)(F.ws + WS_MOD);
    for (int m = gw; m < M; m += NGW) {
        const int b = m >> 11;
        const GAS f32x4* xr = (const GAS f32x4*)(src + (size_t)m * D) + F.lane;
        f32x4 v[4]; float s = 0.f;
#pragma unroll
        for (int j = 0; j < 4; ++j) { v[j] = xr[64 * j]; s += (v[j].x * v[j].x + v[j].y * v[j].y) + (v[j].z * v[j].z + v[j].w * v[j].w); }
        const float rstd = 1.0f / sqrtf(wave_sum(s) * (1.f / D) + eps);
        GAS unsigned long long* o8 = (GAS unsigned long long*)(dst + (size_t)m * D) + F.lane;
#pragma unroll
        for (int j = 0; j < 4; ++j) { const int col = 4 * F.lane + 256 * j;
            const f32x4 w = *(const f32x4*)(nw + col), sc = *(const f32x4*)(mod + b * DIN + sc_off + col), sh = *(const f32x4*)(mod + b * DIN + sh_off + col);
            const f32x4 hq = v[j] * rstd * w * (sc + 1.0f) + sh;
            o8[64 * j] = (unsigned long long)pk2(hq.x, hq.y) | ((unsigned long long)pk2(hq.z, hq.w) << 32); }
    }
}
__device__ __forceinline__ void fill_bias_table(Frame& F, LAS float* bl2) {
    const float* rb = F.in[11];
    for (int i = F.tid; i < 8 * 128; i += NWAVES * 64) { const int h = i >> 7, d = i & 127;
        int bk = d;
        if (d >= 16) { bk = 16 + (int)(log2f((float)d * (1.f / 16.f)) * (16.f / 3.f)); if (bk > 31) bk = 31; }
        bl2[i] = rb[bk * 8 + h] * LOG2E; }
}
__device__ __forceinline__ void naive_attn_unit(Frame& F, int b, int vh, int qc, const bf16* Qb, const bf16* Kb, const bf16* Vb, bf16* O1, bf16* O2, LAS float* Kt, LAS float* Vt, const LAS float* bl2) {
    const int h = vh >> 2, map = (vh >> 1) & 1, vhalf = vh & 1;
    const int qcol = (2 * h + map) * 64, vcol = (2 * h + vhalf) * 64;
    const int qpos = qc * 512 + F.wave * 64 + F.lane;
    const size_t rowb = (size_t)b * SEQ;
    float q[64], o[64];
    { const v4u* qp = (const v4u*)(Qb + (rowb + qpos) * D + qcol);
#pragma unroll
      for (int i = 0; i < 8; ++i) { const v4u w = qp[i]; q[8 * i + 0] = bflo(w.x); q[8 * i + 1] = bfhi(w.x); q[8 * i + 2] = bflo(w.y); q[8 * i + 3] = bfhi(w.y); q[8 * i + 4] = bflo(w.z); q[8 * i + 5] = bfhi(w.z); q[8 * i + 6] = bflo(w.w); q[8 * i + 7] = bfhi(w.w); } }
#pragma unroll
    for (int d = 0; d < 64; ++d) o[d] = 0.f;
    float mx = -1e30f, l = 0.f;
    const int ntile = (qc * 512 + 512) / 64, wmaxq = qc * 512 + F.wave * 64 + 63;
    for (int kt = 0; kt < ntile; ++kt) {
        __syncthreads();
        { const int key = F.tid >> 3, d0 = (F.tid & 7) * 8;
          const v4u kw = *(const v4u*)(Kb + (rowb + kt * 64 + key) * D + qcol + d0), vw = *(const v4u*)(Vb + (rowb + kt * 64 + key) * D + vcol + d0);
          LAS float* kd = Kt + key * 64 + d0; LAS float* vd = Vt + key * 64 + d0;
          kd[0] = bflo(kw.x); kd[1] = bfhi(kw.x); kd[2] = bflo(kw.y); kd[3] = bfhi(kw.y); kd[4] = bflo(kw.z); kd[5] = bfhi(kw.z); kd[6] = bflo(kw.w); kd[7] = bfhi(kw.w);
          vd[0] = bflo(vw.x); vd[1] = bfhi(vw.x); vd[2] = bflo(vw.y); vd[3] = bfhi(vw.y); vd[4] = bflo(vw.z); vd[5] = bfhi(vw.z); vd[6] = bflo(vw.w); vd[7] = bfhi(vw.w); }
        __syncthreads();
        if (kt * 64 <= wmaxq) {
            for (int j = 0; j < 64; ++j) {
                const int dist = qpos - (kt * 64 + j);
                float s = 0.f;
#pragma unroll
                for (int d4 = 0; d4 < 16; ++d4) { const f32x4 kv = *(const LAS f32x4*)(Kt + j * 64 + 4 * d4); s += q[4 * d4] * kv.x + q[4 * d4 + 1] * kv.y + q[4 * d4 + 2] * kv.z + q[4 * d4 + 3] * kv.w; }
                const int dc = dist < 0 ? 0 : (dist > 127 ? 127 : dist);
                s += bl2[h * 128 + dc];
                if (dist < 0) s = -INFINITY;
                const float mn = fmaxf(mx, s), alpha = __builtin_amdgcn_exp2f(mx - mn), p = __builtin_amdgcn_exp2f(s - mn);
                l = l * alpha + p; mx = mn;
#pragma unroll
                for (int d4 = 0; d4 < 16; ++d4) { const f32x4 vv = *(const LAS f32x4*)(Vt + j * 64 + 4 * d4);
                    o[4 * d4] = o[4 * d4] * alpha + p * vv.x; o[4 * d4 + 1] = o[4 * d4 + 1] * alpha + p * vv.y; o[4 * d4 + 2] = o[4 * d4 + 2] * alpha + p * vv.z; o[4 * d4 + 3] = o[4 * d4 + 3] * alpha + p * vv.w; }
            }
        }
    }
    const float inv = 1.0f / l;
    v4u* op = (v4u*)((map ? O2 : O1) + (rowb + qpos) * D + vcol);
#pragma unroll
    for (int i = 0; i < 8; ++i) { v4u w; w.x = pk2(o[8 * i] * inv, o[8 * i + 1] * inv); w.y = pk2(o[8 * i + 2] * inv, o[8 * i + 3] * inv); w.z = pk2(o[8 * i + 4] * inv, o[8 * i + 5] * inv); w.w = pk2(o[8 * i + 6] * inv, o[8 * i + 7] * inv); op[i] = w; }
}
__device__ __forceinline__ f32x4 ld4bf(const bf16* p) { const unsigned long long w = *(const unsigned long long*)p; const unsigned lo = (unsigned)w, hi = (unsigned)(w >> 32); return (f32x4){bflo(lo), bfhi(lo), bflo(hi), bfhi(hi)}; }
template <int W> __device__ __forceinline__ void pool_item(const bf16* P, bf16* PO, int b, int chunk, int g, int lane) {
    const int t0 = chunk * 128, col = g * 256 + lane * 4; const size_t rowb = (size_t)b * SEQ;
    f32x4 ring[16];
#pragma unroll
    for (int i = 0; i < 16; ++i) { const int t = t0 - 16 + i; ring[i] = (t >= 0) ? ld4bf(P + (rowb + t) * D + col) : (f32x4){0.f, 0.f, 0.f, 0.f}; }
    for (int blk = 0; blk < 8; ++blk) {
#pragma unroll
        for (int i = 0; i < 16; ++i) { const int t = t0 + blk * 16 + i;
            ring[i] = ld4bf(P + (rowb + t) * D + col);
            f32x4 s = ring[i];
#pragma unroll
            for (int j = 1; j < W; ++j) s += ring[(i - j) & 15];
            const int cnt = (t + 1 < W) ? (t + 1) : W;
            const f32x4 r = s * (1.0f / (float)cnt) - ring[i];
            *(unsigned long long*)(PO + (rowb + t) * D + col) = (unsigned long long)pk2(r.x, r.y) | ((unsigned long long)pk2(r.z, r.w) << 32); }
    }
}
__device__ __forceinline__ void attn_combine_rows(Frame& F, const bf16* O1, const bf16* O2, const bf16* GA, bf16* MG) {
    const int gw = F.vcu * NWAVES + F.wave, NGW = F.G * NWAVES;
    float lam;
    { const float a = F.in[6][F.lane] * F.in[7][F.lane], bq = F.in[8][F.lane] * F.in[9][F.lane]; lam = __expf(wave_sum(a)) - __expf(wave_sum(bq)) + 0.2f; }
    float sw[8];
    { const float* sp = F.in[10] + ((8 * F.lane) & 127);
#pragma unroll
      for (int i = 0; i < 8; ++i) sw[i] = sp[i] * 0.8f; }
    for (int m = gw; m < M; m += NGW) {
#pragma unroll
        for (int half = 0; half < 2; ++half) { const size_t off = (size_t)m * D + half * 512 + 8 * F.lane;
            const v4u a1 = *(const v4u*)(O1 + off), a2 = *(const v4u*)(O2 + off), ga = *(const v4u*)(GA + off);
            float d[8], g[8];
            d[0] = bflo(a1.x) - lam * bflo(a2.x); d[1] = bfhi(a1.x) - lam * bfhi(a2.x); d[2] = bflo(a1.y) - lam * bflo(a2.y); d[3] = bfhi(a1.y) - lam * bfhi(a2.y);
            d[4] = bflo(a1.z) - lam * bflo(a2.z); d[5] = bfhi(a1.z) - lam * bfhi(a2.z); d[6] = bflo(a1.w) - lam * bflo(a2.w); d[7] = bfhi(a1.w) - lam * bfhi(a2.w);
            g[0] = bflo(ga.x); g[1] = bfhi(ga.x); g[2] = bflo(ga.y); g[3] = bfhi(ga.y); g[4] = bflo(ga.z); g[5] = bfhi(ga.z); g[6] = bflo(ga.w); g[7] = bfhi(ga.w);
            float ss = 0.f;
#pragma unroll
            for (int i = 0; i < 8; ++i) ss += d[i] * d[i];
            ss += __shfl_xor(ss, 1); ss += __shfl_xor(ss, 2); ss += __shfl_xor(ss, 4); ss += __shfl_xor(ss, 8);
            const float r = 1.0f / sqrtf(ss * (1.f / 128.f) + 1e-5f);
            float o[8];
#pragma unroll
            for (int i = 0; i < 8; ++i) o[i] = sigm(g[i]) * d[i] * r * sw[i];
            v4u w; w.x = pk2(o[0], o[1]); w.y = pk2(o[2], o[3]); w.z = pk2(o[4], o[5]); w.w = pk2(o[6], o[7]);
            *(v4u*)(MG + off) = w; }
    }
}
__device__ __forceinline__ void wave_argmax(float& bv, int& bi) {
#pragma unroll
    for (int o = 1; o < 64; o <<= 1) { const float ov = __shfl_xor(bv, o); const int oi = __shfl_xor(bi, o); if (ov > bv || (ov == bv && oi < bi)) { bv = ov; bi = oi; } }
}
__device__ __forceinline__ void naive_retrieval(Frame& F, const bf16* Q2, const bf16* KEYS, int* SELI, float* SELG) {
    const int gw = F.vcu * NWAVES + F.wave, NGW = F.G * NWAVES, lane = F.lane;
    LAS float* qf = (LAS float*)(F.lds + F.wave * 16384);
    for (int t = gw; t < M; t += NGW) {
#pragma unroll
        for (int j = 0; j < 4; ++j) { const v4u w = *(const v4u*)(Q2 + (size_t)t * DQ2 + 512 * j + 8 * lane); LAS float* qd = qf + 512 * j + 8 * lane;
            qd[0] = bflo(w.x); qd[1] = bfhi(w.x); qd[2] = bflo(w.y); qd[3] = bfhi(w.y); qd[4] = bflo(w.z); qd[5] = bfhi(w.z); qd[6] = bflo(w.w); qd[7] = bfhi(w.w); }
        LDS_WAIT(); asm volatile("" ::: "memory");
        for (int h = 0; h < 8; ++h) {
            float tv[2]; int ti[2];
#pragma unroll
            for (int half = 0; half < 2; ++half) {
                const bf16* kb = KEYS + (size_t)((half * 8 + h) * 128) * 128;
                float s0 = 0.f, s1 = 0.f;
#pragma unroll 4
                for (int d8 = 0; d8 < 16; ++d8) {
                    const v4u k0 = *(const v4u*)(kb + lane * 128 + 8 * d8), k1 = *(const v4u*)(kb + (lane + 64) * 128 + 8 * d8);
                    const f32x4 qa = *(const LAS f32x4*)(qf + h * 256 + half * 128 + 8 * d8), qb = *(const LAS f32x4*)(qf + h * 256 + half * 128 + 8 * d8 + 4);
                    s0 += qa.x * bflo(k0.x) + qa.y * bfhi(k0.x) + qa.z * bflo(k0.y) + qa.w * bfhi(k0.y) + qb.x * bflo(k0.z) + qb.y * bfhi(k0.z) + qb.z * bflo(k0.w) + qb.w * bfhi(k0.w);
                    s1 += qa.x * bflo(k1.x) + qa.y * bfhi(k1.x) + qa.z * bflo(k1.y) + qa.w * bfhi(k1.y) + qb.x * bflo(k1.z) + qb.y * bfhi(k1.z) + qb.z * bflo(k1.w) + qb.w * bfhi(k1.w);
                }
                float myv = 0.f; int myi = 0;
                for (int r = 0; r < 16; ++r) {
                    float bv = s0; int bi = lane; if (s1 > bv) { bv = s1; bi = lane + 64; }
                    wave_argmax(bv, bi);
                    if (lane == r) { myv = bv; myi = bi; }
                    if (bi == lane) s0 = -INFINITY; if (bi == lane + 64) s1 = -INFINITY;
                }
                tv[half] = myv; ti[half] = myi;
            }
            float cv[4];
#pragma unroll
            for (int r = 0; r < 4; ++r) cv[r] = __shfl(tv[0], lane >> 2) + __shfl(tv[1], (lane & 3) * 4 + r);
            float sv = 0.f; int se = 0;
            for (int k = 0; k < 16; ++k) {
                float bv = cv[0]; int bi = lane * 4;
#pragma unroll
                for (int r = 1; r < 4; ++r) if (cv[r] > bv) { bv = cv[r]; bi = lane * 4 + r; }
                wave_argmax(bv, bi);
                const int e = __shfl(ti[0], bi >> 4) * 128 + __shfl(ti[1], bi & 15);
                if (lane == k) { sv = bv; se = e; }
#pragma unroll
                for (int r = 0; r < 4; ++r) if (bi == lane * 4 + r) cv[r] = -INFINITY;
            }
            const float mxv = __shfl(sv, 0);
            float ev = (lane < 16) ? __expf(sv - mxv) : 0.f;
            float sum = ev; sum += __shfl_xor(sum, 1); sum += __shfl_xor(sum, 2); sum += __shfl_xor(sum, 4); sum += __shfl_xor(sum, 8);
            if (lane < 16) { SELI[(size_t)t * NSEL + h * 16 + lane] = se; SELG[(size_t)t * NSEL + h * 16 + lane] = ev / sum; }
        }
        LDS_WAIT(); asm volatile("" ::: "memory");
    }
}
__device__ __forceinline__ void naive_peer(Frame& F, const bf16* H2, const int* SELI, const float* SELG) {
    const int gw = F.vcu * NWAVES + F.wave, NGW = F.G * NWAVES, lane = F.lane;
    const float* down = F.in[19]; const float* up = F.in[20]; const float* nfw = F.in[21];
    const float* mod = (const float*)(F.ws + WS_MOD);
    for (int t = gw; t < M; t += NGW) {
        const int b = t >> 11;
        f32x4 hv[4], acc[4];
#pragma unroll
        for (int j = 0; j < 4; ++j) { hv[j] = ld4bf(H2 + (size_t)t * D + 4 * lane + 256 * j); acc[j] = (f32x4){0.f, 0.f, 0.f, 0.f}; }
        for (int s = 0; s < NSEL; ++s) {
            const int e = __builtin_amdgcn_readfirstlane(SELI[(size_t)t * NSEL + s]); const float g = SELG[(size_t)t * NSEL + s];
            const f32x4* dr = (const f32x4*)(down + (size_t)e * D) + lane; const f32x4* ur = (const f32x4*)(up + (size_t)e * D) + lane;
            float dot = 0.f;
#pragma unroll
            for (int j = 0; j < 4; ++j) { const f32x4 dv = dr[64 * j]; dot += (hv[j].x * dv.x + hv[j].y * dv.y) + (hv[j].z * dv.z + hv[j].w * dv.w); }
            dot = wave_sum(dot);
            const float w = g * 0.5f * dot * (1.0f + erff(dot * 0.70710678118654752f));
#pragma unroll
            for (int j = 0; j < 4; ++j) acc[j] += ur[64 * j] * w;
        }
        f32x4 x2[4]; float ss = 0.f;
#pragma unroll
        for (int j = 0; j < 4; ++j) { const int col = 4 * lane + 256 * j; const f32x4 xv = *(const f32x4*)(F.out + (size_t)t * D + col), g2 = *(const f32x4*)(mod + b * DIN + 5120 + col);
            x2[j] = xv + g2 * acc[j]; ss += (x2[j].x * x2[j].x + x2[j].y * x2[j].y) + (x2[j].z * x2[j].z + x2[j].w * x2[j].w); }
        const float r = 1.0f / sqrtf(wave_sum(ss) * (1.f / D) + 1e-6f);
#pragma unroll
        for (int j = 0; j < 4; ++j) { const int col = 4 * lane + 256 * j; *(f32x4*)(F.out + (size_t)t * D + col) = x2[j] * r * *(const f32x4*)(nfw + col); }
    }
}

#ifndef PHMASK
#define PHMASK 0xFFFF
#endif
#define PH(k) ((PHMASK >> (k)) & 1)
struct Args { const float* in[22]; float* out; unsigned char* ws; };
__global__ void __launch_bounds__(NWAVES * 64, 2) fwd_megakernel(Args args) {
    extern __shared__ __attribute__((aligned(16))) unsigned char lds[];
    Frame F;
    F.lds = (LAS unsigned char*)lds; F.MISC = (volatile LAS unsigned*)(F.lds + MISC_OFF);
    F.tid = threadIdx.x; F.lane = F.tid & 63; F.wave = __builtin_amdgcn_readfirstlane(F.tid >> 6);
    F.G = gridDim.x; { const int bx = blockIdx.x; F.vcu = (F.G % 8 == 0) ? (bx % 8) * (F.G / 8) + bx / 8 : bx; }
#pragma unroll
    for (int i = 0; i < 22; ++i) F.in[i] = args.in[i];
    F.out = args.out; F.ws = args.ws; F.ctl = (gu32*)(args.ws + WS_CTL);
    for (int u = F.tid; u < (LDS_BYTES - LDSCTL_OFF) / 4; u += NWAVES * 64) ((LAS unsigned*)(F.lds + LDSCTL_OFF))[u] = 0u;
    __syncthreads();
    XcdBarrier bar = xcd_barrier_post((unsigned*)(F.ctl + CW_BAR), F.MISC + 8);
    unsigned char* ws = args.ws;
    bf16* XN = (bf16*)(ws + WS_XN); bf16* Qb = (bf16*)(ws + WS_Q); bf16* Kb = (bf16*)(ws + WS_K); bf16* Vb = (bf16*)(ws + WS_V); bf16* Pb = (bf16*)(ws + WS_P);
    bf16* GAb = (bf16*)(ws + WS_GA); bf16* GPb = (bf16*)(ws + WS_GP); bf16* MG = (bf16*)(ws + WS_MG); bf16* Q2 = (bf16*)(ws + WS_Q2);
    bf16* O1 = XN; bf16* O2 = (bf16*)F.out; bf16* POOLED = (bf16*)F.out + (size_t)M * D;
    const float* mod = (const float*)(ws + WS_MOD);
    const int gw = F.vcu * NWAVES + F.wave, NGW = F.G * NWAVES;

    if (PH(0)) p0a_prologue(F);
    xcd_barrier(bar);
    if (PH(1)) norm_mod_rows(F, F.in[0], F.in[4], 0, 1024, XN, 1e-6f);
    xcd_barrier(bar);
    if (PH(2)) { pg8::Gemm g{XN, (const bf16*)(ws + WS_WIN), M, DIN, D, D, 0}; pg8::StaticOrder S; S.init(M, DIN, F.G, (int)blockIdx.x);
      pg8::EpiBf16<0> E{Qb, D, nullptr, D, (size_t)(WS_K - WS_Q) / 2, C2};
      pg8::gemm_phase<pg8::EpiBf16<0>, pg8::StaticOrder, true, true>(F.lds, g, S, E); }
    xcd_barrier(bar);
    if (PH(3)) { LAS float* Kt = (LAS float*)F.lds; LAS float* Vt = Kt + 4096; LAS float* bl2 = Vt + 4096;
      fill_bias_table(F, bl2);
      for (int i = 0; i < 8; ++i) { const int u = i * F.G + F.vcu; if (u >= BATCH * 32 * 4) break;
          const int qc = ((u & 3) + (u >> 8)) & 3, vh = (u >> 2) & 31, b = u >> 7;
          naive_attn_unit(F, b, vh, qc, Qb, Kb, Vb, O1, O2, Kt, Vt, bl2); }
      for (int it = gw; it < BATCH * 16 * 4; it += NGW) { const int g = it & 3, chunk = (it >> 2) & 15, b = it >> 6;
          if (g == 0) pool_item<2>(Pb, POOLED, b, chunk, 0, F.lane); else if (g == 1) pool_item<4>(Pb, POOLED, b, chunk, 1, F.lane);
          else if (g == 2) pool_item<8>(Pb, POOLED, b, chunk, 2, F.lane); else pool_item<16>(Pb, POOLED, b, chunk, 3, F.lane); } }
    xcd_barrier(bar);
    if (PH(4)) attn_combine_rows(F, O1, O2, GAb, MG);
    xcd_barrier(bar);
    if (PH(5)) { pg8::Gemm g{POOLED, (const bf16*)(ws + WS_WPOOL), M, D, 256, D, 256}; pg8::StaticOrder S; S.init(M, D, F.G, (int)blockIdx.x);
      pg8::EpiPool E{MG, GPb, D};
      pg8::gemm_phase<pg8::EpiPool, pg8::StaticOrder, true, true>(F.lds, g, S, E); }
    xcd_barrier(bar);
    if (PH(6)) { pg8::Gemm g{MG, (const bf16*)(ws + WS_WOUT), M, D, D, D, 0}; pg8::StaticOrder S; S.init(M, D, F.G, (int)blockIdx.x);
      pg8::EpiResid E{F.in[0], F.out, mod + 2048, D, DIN, SEQ};
      pg8::gemm_phase<pg8::EpiResid, pg8::StaticOrder, true, true>(F.lds, g, S, E); }
    xcd_barrier(bar);
    if (PH(7)) norm_mod_rows(F, F.out, F.in[15], 3072, 4096, XN, 1e-6f);
    xcd_barrier(bar);
    if (PH(8)) { pg8::Gemm g{XN, (const bf16*)(ws + WS_WQ), M, DQ2, D, D, 0}; pg8::StaticOrder S; S.init(M, DQ2, F.G, (int)blockIdx.x);
      pg8::EpiBf16<0> E{Q2, DQ2, nullptr, 0, 0, 1.f};
      pg8::gemm_phase<pg8::EpiBf16<0>, pg8::StaticOrder, true, true>(F.lds, g, S, E); }
    xcd_barrier(bar);
    if (PH(9)) naive_retrieval(F, Q2, (const bf16*)(ws + WS_KEYS), (int*)(ws + WS_SELI), (float*)(ws + WS_SELG));
    xcd_barrier(bar);
    if (PH(10)) naive_peer(F, XN, (const int*)(ws + WS_SELI), (const float*)(ws + WS_SELG));
}

extern "C" void kernel_launch(void* const* d_in, const int* in_sizes, int n_in, void* d_out, int out_size, void* d_ws, size_t ws_size, hipStream_t stream) {
    static int grid = 0;
    if (grid == 0) {
        if (n_in != 22 || in_sizes[0] != M * D || out_size != M * D || ws_size < WS_END) { fprintf(stderr, "kernel_launch: unexpected shapes/workspace (n_in %d, in0 %d, out %d, ws %zu < %zu); nothing launched\n", n_in, n_in > 0 ? in_sizes[0] : -1, out_size, ws_size, (size_t)WS_END); grid = -1; return; }
        int dev = 0, cus = 0;
        if (hipGetDevice(&dev) != hipSuccess || hipDeviceGetAttribute(&cus, hipDeviceAttributeMultiprocessorCount, dev) != hipSuccess) { grid = -1; return; }
        if (hipFuncSetAttribute((const void*)fwd_megakernel, hipFuncAttributeMaxDynamicSharedMemorySize, LDS_BYTES) != hipSuccess) { fprintf(stderr, "kernel_launch: hipFuncSetAttribute failed\n"); grid = -1; return; }
        int per_cu = 0;
        if (hipOccupancyMaxActiveBlocksPerMultiprocessor(&per_cu, (const void*)fwd_megakernel, NWAVES * 64, LDS_BYTES) != hipSuccess || per_cu < 1) fprintf(stderr, "kernel_launch: occupancy query reports %d\n", per_cu);
        (void)hipGetLastError();
        grid = cus;
    }
    if (grid < 0) return;
    if (hipMemsetAsync((char*)d_ws + WS_CTL, 0, CTL_ZERO_BYTES, stream) != hipSuccess) { fprintf(stderr, "kernel_launch: memset failed\n"); return; }
    Args a{};
    for (int i = 0; i < 22; ++i) a.in[i] = (const float*)d_in[i];
    a.out = (float*)d_out; a.ws = (unsigned char*)d_ws;
    hipLaunchKernelGGL(fwd_megakernel, dim3(grid), dim3(NWAVES * 64), LDS_BYTES, stream, a);
}
```

```cpp
#include <hip/hip_runtime.h>
#include <cstdio>
#include <cstdint>
namespace pg8 {
#define PG8_LAS __attribute__((address_space(3)))
typedef unsigned short bf16_t;
typedef short bf16x8 __attribute__((ext_vector_type(8)));
typedef float f32x4 __attribute__((ext_vector_type(4)));
typedef unsigned u32x4 __attribute__((ext_vector_type(4)));
constexpr int BM = 256, BK = 64, HALF = 128, HTB = HALF * BK * 2  , STAGE_BYTES = 8 * HTB, NXCD = 8, WGM = 8;

__host__ __device__ __forceinline__ int lds_byte(int r, int c) { const int st = (r >> 4) * 2 + (c >> 5), rr = r & 15, cc = c & 31, ob = rr * 64 + cc * 2; return st * 1024 + (ob ^ (((ob >> 9) & 1) << 5)); }
__host__ __device__ __forceinline__ void stage_rc(int b, int& R, int& C) { const int st = b / 1024, sb = b % 1024, swz = sb ^ (((sb >> 9) & 1) << 5); R = (st >> 1) * 16 + swz / 64; C = (st & 1) * 32 + (swz % 64) / 2; }
__host__ __device__ __forceinline__ int perm32(int rho) { const int n = rho >> 4, i = rho & 15; return 8 * (i >> 2) + 4 * n + (i & 3); }

struct Unit { int pm, pn; };
struct Gemm { const bf16_t* A; const bf16_t* Bt; int M, N, K, lda, a_pn; };

struct StaticOrder {
    int nM, nN, nwg, G, c;
    __host__ __device__ void init(int M, int N, int G_, int c_) { nM = M / BM; nN = N / BM; nwg = nM * nN; G = G_; c = c_; }
    __host__ __device__ bool next(int i, Unit& u) const {
        const long L = (long)i * G + c; if (L >= nwg) return false;
        int wgid = (int)L; { const int q = nwg / NXCD, r = nwg % NXCD, xcd = wgid % NXCD, off = wgid / NXCD; wgid = (xcd < r ? xcd * (q + 1) : r * (q + 1) + (xcd - r) * q) + off; }
        const int nig = WGM * nN, gid = wgid / nig, fm = gid * WGM, gsz = (nM - fm) < WGM ? (nM - fm) : WGM;
        u.pm = fm + ((wgid % nig) % gsz); u.pn = (wgid % nig) / gsz; return true;
    }
    __device__ __forceinline__ void a_ready(const Unit&) const {}
    __device__ __forceinline__ void done(const Unit&) const {}
};

__device__ __forceinline__ unsigned cvt_pk_bf16(float lo, float hi) { unsigned r; asm volatile("v_cvt_pk_bf16_f32 %0, %1, %2" : "=v"(r) : "v"(lo), "v"(hi)); return r; }
typedef float f32x2 __attribute__((ext_vector_type(2)));
__device__ __forceinline__ f32x2 gelu_pk(f32x2 v) {
    const f32x2 av = __builtin_elementwise_abs(v), d = av * 0.2316418882f + 1.0f;
    f32x2 t; t.x = __builtin_amdgcn_rcpf(d.x); t.y = __builtin_amdgcn_rcpf(d.y);
    f32x2 q = t * 0.5307027145f + (-0.7265760135f); q = q * t + 0.7107068705f; q = q * t + (-0.142248368f); q = q * t + 0.127414796f; q = q * t;
    const f32x2 s = (v * v) * (-0.72134752044f);
    f32x2 e; e.x = __builtin_amdgcn_exp2f(s.x); e.y = __builtin_amdgcn_exp2f(s.y);
    const f32x2 m = v * (q * e), r = v - m;
    f32x2 o; o.x = v.x < 0.f ? m.x : r.x; o.y = v.y < 0.f ? m.y : r.y; return o;
}

template <int ACT  > struct EpiBf16 {
    static constexpr bool PERM = true, AFTER_DRAIN = false; static_assert(ACT == 0 || ACT == 1, "EpiBf16: ACT is 0 (none) or 1 (gelu_pk)");
    bf16_t* O; int ldc; const float* bias; int split_cols; size_t split_stride; float scale0;
    __device__ __forceinline__ void operator()(const f32x4 (&acc)[2][2][4][2], const Unit& u, int wr, int wc, int fr, int fq) const {
        const int row0 = u.pm * BM + wr * 64 + fr; int colt = u.pn * BM; bf16_t* base = O;
        float sc = 1.f; if (split_cols) { const int t = colt / split_cols; base += (size_t)t * split_stride; colt -= t * split_cols; if (t == 0) sc = scale0; }
        const int col0 = colt + wc * 32 + 8 * fq, bcol0 = u.pn * BM + wc * 32 + 8 * fq;
        f32x4 bv[2][2];
#pragma unroll
        for (int bj = 0; bj < 2; ++bj)
#pragma unroll
            for (int n = 0; n < 2; ++n) bv[bj][n] = bias ? *(const f32x4*)(bias + bcol0 + bj * HALF + 4 * n) : (f32x4){0.f, 0.f, 0.f, 0.f};
#pragma unroll
        for (int ai = 0; ai < 2; ++ai)
#pragma unroll
            for (int m = 0; m < 4; ++m) { bf16_t* rowp = base + (size_t)(row0 + ai * HALF + m * 16) * ldc + col0;
#pragma unroll
                for (int bj = 0; bj < 2; ++bj) { f32x4 v0 = acc[ai][bj][m][0] + bv[bj][0], v1 = acc[ai][bj][m][1] + bv[bj][1];
                    if (ACT == 1) { f32x2 a = gelu_pk((f32x2){v0[0], v0[1]}), b = gelu_pk((f32x2){v0[2], v0[3]}), c = gelu_pk((f32x2){v1[0], v1[1]}), d = gelu_pk((f32x2){v1[2], v1[3]});
                        v0 = (f32x4){a.x, a.y, b.x, b.y}; v1 = (f32x4){c.x, c.y, d.x, d.y}; }
                    v0 = v0 * sc; v1 = v1 * sc; u32x4 w; w.x = cvt_pk_bf16(v0[0], v0[1]); w.y = cvt_pk_bf16(v0[2], v0[3]); w.z = cvt_pk_bf16(v1[0], v1[1]); w.w = cvt_pk_bf16(v1[2], v1[3]);
                    *(u32x4*)(rowp + bj * HALF) = w; } }
    }
};
__device__ __forceinline__ float bf_lo(unsigned w) { return __builtin_bit_cast(float, w << 16); }
__device__ __forceinline__ float bf_hi(unsigned w) { return __builtin_bit_cast(float, w & 0xffff0000u); }
__device__ __forceinline__ float sigmoidf_(float x) { return __builtin_amdgcn_rcpf(1.0f + __builtin_amdgcn_exp2f(-1.4426950408889634f * x)); }
struct EpiPool {
    static constexpr bool PERM = true, AFTER_DRAIN = false;
    bf16_t* MG; const bf16_t* GP; int ldc;
    __device__ __forceinline__ void operator()(const f32x4 (&acc)[2][2][4][2], const Unit& u, int wr, int wc, int fr, int fq) const {
        const int row0 = u.pm * BM + wr * 64 + fr, col0 = u.pn * BM + wc * 32 + 8 * fq;
#pragma unroll
        for (int ai = 0; ai < 2; ++ai)
#pragma unroll
            for (int m = 0; m < 4; ++m) { const size_t ro = (size_t)(row0 + ai * HALF + m * 16) * ldc + col0;
#pragma unroll
                for (int bj = 0; bj < 2; ++bj) {
                    const u32x4 mg = *(const u32x4*)(MG + ro + bj * HALF), gp = *(const u32x4*)(GP + ro + bj * HALF);
                    const f32x4 a0 = acc[ai][bj][m][0], a1 = acc[ai][bj][m][1];
                    u32x4 w;
                    w.x = cvt_pk_bf16(bf_lo(mg.x) + a0[0] * sigmoidf_(bf_lo(gp.x)), bf_hi(mg.x) + a0[1] * sigmoidf_(bf_hi(gp.x)));
                    w.y = cvt_pk_bf16(bf_lo(mg.y) + a0[2] * sigmoidf_(bf_lo(gp.y)), bf_hi(mg.y) + a0[3] * sigmoidf_(bf_hi(gp.y)));
                    w.z = cvt_pk_bf16(bf_lo(mg.z) + a1[0] * sigmoidf_(bf_lo(gp.z)), bf_hi(mg.z) + a1[1] * sigmoidf_(bf_hi(gp.z)));
                    w.w = cvt_pk_bf16(bf_lo(mg.w) + a1[2] * sigmoidf_(bf_lo(gp.w)), bf_hi(mg.w) + a1[3] * sigmoidf_(bf_hi(gp.w)));
                    *(u32x4*)(MG + ro + bj * HALF) = w; }
                asm volatile("" ::: "memory"); }
    }
};
struct EpiResidBf {
    static constexpr bool PERM = true, AFTER_DRAIN = false;
    const float* x; bf16_t* out; const float* gate; int ldc, gpitch, rows_per_b;
    __device__ __forceinline__ void operator()(const f32x4 (&acc)[2][2][4][2], const Unit& u, int wr, int wc, int fr, int fq) const {
        const int row0 = u.pm * BM + wr * 64 + fr, col0 = u.pn * BM + wc * 32 + 8 * fq;
        const float* gb = gate + (size_t)((u.pm * BM) / rows_per_b) * gpitch + col0;
        f32x4 gv[2][2];
#pragma unroll
        for (int bj = 0; bj < 2; ++bj)
#pragma unroll
            for (int n = 0; n < 2; ++n) gv[bj][n] = *(const f32x4*)(gb + bj * HALF + 4 * n);
#pragma unroll
        for (int ai = 0; ai < 2; ++ai)
#pragma unroll
            for (int m = 0; m < 4; ++m) { const size_t ro = (size_t)(row0 + ai * HALF + m * 16) * ldc + col0;
#pragma unroll
                for (int bj = 0; bj < 2; ++bj) { const f32x4 x0 = *(const f32x4*)(x + ro + bj * HALF), x1 = *(const f32x4*)(x + ro + bj * HALF + 4);
                    const f32x4 v0 = x0 + gv[bj][0] * acc[ai][bj][m][0], v1 = x1 + gv[bj][1] * acc[ai][bj][m][1];
                    u32x4 w; w.x = cvt_pk_bf16(v0[0], v0[1]); w.y = cvt_pk_bf16(v0[2], v0[3]); w.z = cvt_pk_bf16(v1[0], v1[1]); w.w = cvt_pk_bf16(v1[2], v1[3]);
                    *(u32x4*)(out + ro + bj * HALF) = w; } }
    }
};
struct EpiQFrag {
    static constexpr bool PERM = true, AFTER_DRAIN = false;
    bf16_t* O;
    __device__ __forceinline__ void operator()(const f32x4 (&acc)[2][2][4][2], const Unit& u, int wr, int wc, int fr, int fq) const {
        const int row0 = u.pm * BM + wr * 64 + fr;
#pragma unroll
        for (int ai = 0; ai < 2; ++ai)
#pragma unroll
            for (int m = 0; m < 4; ++m) { const int r = row0 + ai * HALF + m * 16;
#pragma unroll
                for (int bj = 0; bj < 2; ++bj) { const f32x4 v0 = acc[ai][bj][m][0], v1 = acc[ai][bj][m][1];
                    u32x4 w; w.x = cvt_pk_bf16(v0[0], v0[1]); w.y = cvt_pk_bf16(v0[2], v0[3]); w.z = cvt_pk_bf16(v1[0], v1[1]); w.w = cvt_pk_bf16(v1[2], v1[3]);
                    *(u32x4*)(O + ((size_t)(((r >> 5) * 8 + u.pn) * 2 + bj) * 4096 + (wc * 2 + (fq >> 1)) * 512 + ((fq & 1) * 32 + (r & 31)) * 8)) = w; } }
    }
};
struct EpiInProj {
    static constexpr bool PERM = true, AFTER_DRAIN = false;
    bf16_t* O; size_t stride; float scale0;
    __device__ __forceinline__ void operator()(const f32x4 (&acc)[2][2][4][2], const Unit& u, int wr, int wc, int fr, int fq) const {
        const int row0 = u.pm * BM + wr * 64 + fr; int colt = u.pn * BM; const int t = colt >> 10; colt &= 1023;
        bf16_t* base = O + (size_t)t * stride; const float sc = (t == 0) ? scale0 : 1.f;
        const int col0 = colt + wc * 32 + 8 * fq;
#pragma unroll
        for (int ai = 0; ai < 2; ++ai)
#pragma unroll
            for (int m = 0; m < 4; ++m) { const int r = row0 + ai * HALF + m * 16;
#pragma unroll
                for (int bj = 0; bj < 2; ++bj) { const int c = col0 + bj * HALF; const f32x4 v0 = acc[ai][bj][m][0] * sc, v1 = acc[ai][bj][m][1] * sc;
                    u32x4 w; w.x = cvt_pk_bf16(v0[0], v0[1]); w.y = cvt_pk_bf16(v0[2], v0[3]); w.z = cvt_pk_bf16(v1[0], v1[1]); w.w = cvt_pk_bf16(v1[2], v1[3]);
                    size_t off;
                    if (false) off = (size_t)(((((r >> 11) * 16 + (c >> 6)) * 32 + ((r >> 6) & 31)) * 8 + ((c >> 3) & 7)) * 512 + (r & 63) * 8);
                    else if (false) off = (size_t)((((((r >> 11) * 8 + (c >> 7)) * 32 + ((r >> 6) & 31)) * 4 + ((c >> 5) & 3)) * 64 + (r & 63)) * 32 + (c & 31));
                    else off = (size_t)r * 1024 + c;
                    *(u32x4*)(base + off) = w; } }
    }
};
template <class Epi, class Sched, bool ALIGN_EPI = false, bool SP2 = false>
__device__ __forceinline__ void gemm_phase(PG8_LAS unsigned char* lds, const Gemm g, const Sched& S, const Epi& E) {
    int tid = threadIdx.x; asm volatile("" : "+v"(tid));
    const int wid = __builtin_amdgcn_readfirstlane(tid >> 6), lane = tid & 63, wr = wid >> 2, wc = wid & 3, fr = lane & 15, fq = lane >> 4;
    int K = g.K; asm volatile("" : "+s"(K));
    const int nt = K / BK;
    unsigned voffA[2], voffB[2];
#pragma unroll
    for (int i = 0; i < 2; ++i) { int R, C; stage_rc(tid * 16 + i * 8192, R, C); const int Rb = Epi::PERM ? ((R & ~31) + perm32(R & 31)) : R;
        voffA[i] = (unsigned)(R * g.lda + C) * 2u; voffB[i] = (unsigned)(Rb * K + C) * 2u; }
    const size_t kstep = (size_t)(BK * 2);
    const size_t hstepA = (size_t)HALF * g.lda * 2, hstepB = (size_t)HALF * K * 2;
    const size_t tstepA = 2 * hstepA, tstepB = 2 * hstepB, pnA = (size_t)g.a_pn * 2;
    const unsigned ldsw = (unsigned)wid * 1024u;
    const int aoff = lds_byte(wr * 64 + fr, fq * 8), boff = lds_byte(wc * 32 + fr, fq * 8);
#define PG8_SA(b, h) (((b) * 2 + (h)) * HTB)
#define PG8_SB(b, h) ((4 + (b) * 2 + (h)) * HTB)
#define PG8_STAGE(bufoff, gbase, voff) do { _Pragma("unroll") for (int _i = 0; _i < 2; ++_i) \
        __builtin_amdgcn_global_load_lds((const unsigned*)((const char*)(gbase) + (voff)[_i]), (PG8_LAS unsigned*)(lds + (bufoff) + ldsw + _i * 8192), 16, 0, 0); } while (0)
#define PG8_LDA(dst, b, h) do { _Pragma("unroll") for (int m = 0; m < 4; ++m) _Pragma("unroll") for (int k = 0; k < 2; ++k) dst[m][k] = *(const PG8_LAS bf16x8*)(lds + PG8_SA(b, h) + aoff + m * 2048 + k * 1024); } while (0)
#define PG8_LDB(dst, b, h) do { _Pragma("unroll") for (int n = 0; n < 2; ++n) _Pragma("unroll") for (int k = 0; k < 2; ++k) dst[n][k] = *(const PG8_LAS bf16x8*)(lds + PG8_SB(b, h) + boff + n * 2048 + k * 1024); } while (0)
#define PG8_MMA(ai, bj, At, Bt) do { __builtin_amdgcn_s_setprio(1); _Pragma("unroll") for (int m = 0; m < 4; ++m) _Pragma("unroll") for (int n = 0; n < 2; ++n) _Pragma("unroll") for (int k = 0; k < 2; ++k) \
        acc[ai][bj][m][n] = __builtin_amdgcn_mfma_f32_16x16x32_bf16(Bt[n][k], At[m][k], acc[ai][bj][m][n], 0, 0, 0); __builtin_amdgcn_s_setprio(0); } while (0)
#define PG8_WAIT_V(n) asm volatile("s_waitcnt vmcnt(" #n ")" ::: "memory")
#define PG8_WAIT_L(n) asm volatile("s_waitcnt lgkmcnt(" #n ")" ::: "memory")
#define PG8_BAR __builtin_amdgcn_s_barrier()
#define PG8_SCHED __builtin_amdgcn_sched_barrier(0)
    Unit cur, nxt; int ui = 0;
    if (!S.next(0, cur)) return;
    f32x4 acc[2][2][4][2];
#pragma unroll
    for (int a = 0; a < 2; ++a)
#pragma unroll
        for (int b = 0; b < 2; ++b)
#pragma unroll
            for (int m = 0; m < 4; ++m)
#pragma unroll
                for (int n = 0; n < 2; ++n) acc[a][b][m][n] = (f32x4){0.f, 0.f, 0.f, 0.f};
    bf16x8 At[4][2], B0[2][2], B1[2][2];
    const char* cA = (const char*)g.A + (size_t)cur.pm * tstepA + (size_t)cur.pn * pnA; const char* cB = (const char*)g.Bt + (size_t)cur.pn * tstepB;
    S.a_ready(cur);
    if constexpr (SP2) {
        PG8_STAGE(PG8_SB(0, 0), cB, voffB); PG8_STAGE(PG8_SB(0, 1), cB + hstepB, voffB); PG8_STAGE(PG8_SA(0, 0), cA, voffA); PG8_STAGE(PG8_SA(0, 1), cA + hstepA, voffA);
        if (wr == 1) PG8_BAR;
        PG8_WAIT_V(2); PG8_BAR;
        PG8_STAGE(PG8_SB(1, 0), cB + kstep, voffB); PG8_STAGE(PG8_SA(1, 0), cA + kstep, voffA); PG8_STAGE(PG8_SB(1, 1), cB + hstepB + kstep, voffB);
        PG8_WAIT_V(6); PG8_BAR;
    } else {
        PG8_STAGE(PG8_SB(0, 0), cB, voffB); PG8_STAGE(PG8_SA(0, 0), cA, voffA); PG8_STAGE(PG8_SB(0, 1), cB + hstepB, voffB); PG8_STAGE(PG8_SA(0, 1), cA + hstepA, voffA);
        if (wr == 1) PG8_BAR;
        PG8_WAIT_V(4); PG8_BAR;
        PG8_STAGE(PG8_SB(1, 0), cB + kstep, voffB); PG8_STAGE(PG8_SA(1, 0), cA + kstep, voffA); PG8_STAGE(PG8_SB(1, 1), cB + hstepB + kstep, voffB);
        PG8_WAIT_V(6); PG8_BAR;
    }
    for (;;) {
        const bool has_next = S.next(ui + 1, nxt);
        const char* nA = has_next ? (const char*)g.A + (size_t)nxt.pm * tstepA + (size_t)nxt.pn * pnA : cA; const char* nB = has_next ? (const char*)g.Bt + (size_t)nxt.pn * tstepB : cB;
        for (int t = 0; t < nt; t += 2) {
            const bool last = (t == nt - 2);
            const char* a1 = cA + (size_t)(t + 1) * kstep;
            const char* a2 = last ? nA : cA + (size_t)(t + 2) * kstep; const char* b2 = last ? nB : cB + (size_t)(t + 2) * kstep;
            const char* a3 = a2 + kstep; const char* b3 = b2 + kstep;
            if (last && has_next) S.a_ready(nxt);
            if constexpr (SP2) {
            PG8_LDB(B0, 0, 0); PG8_LDB(B1, 0, 1); PG8_SCHED; PG8_LDA(At, 0, 0); PG8_STAGE(PG8_SA(1, 1), a1 + hstepA, voffA);
            PG8_WAIT_V(8); PG8_WAIT_L(0); PG8_BAR; PG8_MMA(0, 0, At, B0); PG8_MMA(0, 1, At, B1); PG8_BAR; PG8_SCHED;
            PG8_LDA(At, 0, 1); PG8_STAGE(PG8_SB(0, 0), b2, voffB); PG8_STAGE(PG8_SB(0, 1), b2 + hstepB, voffB); PG8_STAGE(PG8_SA(0, 0), a2, voffA);
            PG8_WAIT_V(8); PG8_WAIT_L(0); PG8_BAR; PG8_MMA(1, 0, At, B0); PG8_MMA(1, 1, At, B1); PG8_BAR; PG8_SCHED;
            PG8_LDB(B0, 1, 0); PG8_LDB(B1, 1, 1); PG8_SCHED; PG8_LDA(At, 1, 0); PG8_STAGE(PG8_SA(0, 1), a2 + hstepA, voffA);
            PG8_WAIT_V(8); PG8_WAIT_L(0); PG8_BAR; PG8_MMA(0, 0, At, B0); PG8_MMA(0, 1, At, B1); PG8_BAR; PG8_SCHED;
            PG8_LDA(At, 1, 1); PG8_STAGE(PG8_SB(1, 0), b3, voffB); PG8_STAGE(PG8_SB(1, 1), b3 + hstepB, voffB); PG8_STAGE(PG8_SA(1, 0), a3, voffA);
            PG8_WAIT_V(8); PG8_WAIT_L(0); PG8_BAR; PG8_MMA(1, 0, At, B0); PG8_MMA(1, 1, At, B1); PG8_BAR; PG8_SCHED;
            } else {
            PG8_LDB(B0, 0, 0); PG8_SCHED; PG8_LDA(At, 0, 0); PG8_STAGE(PG8_SA(1, 1), a1 + hstepA, voffA);
            PG8_WAIT_L(8); PG8_BAR; PG8_WAIT_L(0); PG8_MMA(0, 0, At, B0); PG8_BAR; PG8_SCHED;
            PG8_LDB(B1, 0, 1); PG8_STAGE(PG8_SB(0, 0), b2, voffB);
            PG8_BAR; PG8_WAIT_L(0); PG8_MMA(0, 1, At, B1); PG8_BAR;
            PG8_LDA(At, 0, 1); PG8_STAGE(PG8_SA(0, 0), a2, voffA);
            PG8_BAR; PG8_WAIT_L(0); PG8_MMA(1, 0, At, B0); PG8_BAR; PG8_SCHED;
            PG8_STAGE(PG8_SB(0, 1), b2 + hstepB, voffB);
            PG8_WAIT_V(6); PG8_BAR; PG8_MMA(1, 1, At, B1); PG8_BAR;
            PG8_LDB(B0, 1, 0); PG8_SCHED; PG8_LDA(At, 1, 0); PG8_STAGE(PG8_SA(0, 1), a2 + hstepA, voffA);
            PG8_WAIT_L(8); PG8_BAR; PG8_WAIT_L(0); PG8_MMA(0, 0, At, B0); PG8_BAR; PG8_SCHED;
            PG8_LDB(B1, 1, 1); PG8_STAGE(PG8_SB(1, 0), b3, voffB);
            PG8_BAR; PG8_WAIT_L(0); PG8_MMA(0, 1, At, B1); PG8_BAR;
            PG8_LDA(At, 1, 1); PG8_STAGE(PG8_SA(1, 0), a3, voffA);
            PG8_BAR; PG8_WAIT_L(0); PG8_MMA(1, 0, At, B0); PG8_BAR; PG8_SCHED;
            PG8_STAGE(PG8_SB(1, 1), b3 + hstepB, voffB);
            PG8_WAIT_V(6); PG8_BAR; PG8_MMA(1, 1, At, B1); PG8_BAR;
            }
        }
        if constexpr (ALIGN_EPI) { if (wr == 0) PG8_BAR; }
        if constexpr (!Epi::AFTER_DRAIN) { E(acc, cur, wr, wc, fr, fq); S.done(cur); }
        if (!has_next) break;
#pragma unroll
        for (int a = 0; a < 2; ++a)
#pragma unroll
            for (int b = 0; b < 2; ++b)
#pragma unroll
                for (int m = 0; m < 4; ++m)
#pragma unroll
                    for (int n = 0; n < 2; ++n) acc[a][b][m][n] = (f32x4){0.f, 0.f, 0.f, 0.f};
        cur = nxt; cA = nA; cB = nB; ++ui;
        if constexpr (ALIGN_EPI) { if (wr == 1) PG8_BAR; }
    }
    PG8_WAIT_V(0);
    if constexpr (!ALIGN_EPI) { if (wr == 0) PG8_BAR; }
    PG8_BAR;
    if constexpr (Epi::AFTER_DRAIN) { E.fused(acc, cur, wr, wc, fr, fq, lds, wid, lane); S.done(cur); }
#undef PG8_SA
#undef PG8_SB
#undef PG8_STAGE
#undef PG8_LDA
#undef PG8_LDB
#undef PG8_MMA
#undef PG8_WAIT_V
#undef PG8_WAIT_L
#undef PG8_BAR
#undef PG8_SCHED
}
}
#define GAS __attribute__((address_space(1)))
#define LAS __attribute__((address_space(3)))
typedef unsigned short bf16;
typedef unsigned v4u __attribute__((ext_vector_type(4)));
typedef float f32x4 __attribute__((ext_vector_type(4)));
typedef short bf16x8 __attribute__((ext_vector_type(8)));
typedef GAS unsigned gu32;
typedef GAS unsigned long long gu64;
#define RLX_AGENT __ATOMIC_RELAXED, __HIP_MEMORY_SCOPE_AGENT
#define LDS_WAIT() asm volatile("s_waitcnt lgkmcnt(0)" ::: "memory")
#define VM_WAIT() asm volatile("s_waitcnt vmcnt(0)" ::: "memory")
__device__ __forceinline__ unsigned long long rt() { return __builtin_amdgcn_s_memrealtime(); }
__device__ __forceinline__ unsigned f2bf(float f) { unsigned u = __builtin_bit_cast(unsigned, f); return (u + 0x7fffu + ((u >> 16) & 1u)) >> 16; }
__device__ __forceinline__ unsigned pk2(float lo, float hi) { return f2bf(lo) | (f2bf(hi) << 16); }

#define XB_TMO      128
#define XB_XCNT(j)  (256  + 64 * (j))
#define XB_XSUB(j)  (1280 + 64 * (j))
#define XB_XGEN(j)  (2304 + 64 * (j))
#define XB_TOP      3328
#define XB_TOPGEN   3392
#define XCD_BAR_WORDS 3456
#define XB_SPIN_CAP (1u << 18)

__device__ __forceinline__ unsigned xb_ld(unsigned* p)              { return __hip_atomic_load(p, __ATOMIC_RELAXED, __HIP_MEMORY_SCOPE_AGENT); }
__device__ __forceinline__ unsigned xb_add(unsigned* p, unsigned v) { return __hip_atomic_fetch_add(p, v, __ATOMIC_RELAXED, __HIP_MEMORY_SCOPE_AGENT); }
__device__ __forceinline__ unsigned xb_xcc_id() { return (unsigned)__builtin_amdgcn_s_getreg((3 << 11) | 20) & 0xFu; }
#define XB_SPIN(cond, bar) do { unsigned _sp = 0; while (cond) { __builtin_amdgcn_s_sleep(1); \
    if ((++_sp & 255u) == 0u) { if (xb_ld(&(bar)[XB_TMO])) break; if (_sp > XB_SPIN_CAP) { atomicAdd(&(bar)[XB_TMO], 1u); break; } } } } while (0)

struct XcdBarrier {
    unsigned* bar; unsigned x;
    volatile LAS unsigned* st;
};

__device__ __forceinline__ XcdBarrier xcd_barrier_post(unsigned* bar, volatile LAS unsigned* st) {
    XcdBarrier b; b.bar = bar; b.x = xb_xcc_id(); b.st = st;
    if (threadIdx.x == 0) (void)xb_add(&bar[XB_XCNT(b.x)], 1u);
    return b;
}
__device__ __forceinline__ void xcd_barrier_complete(unsigned* bar, unsigned x, unsigned& nloc, unsigned& nx) {
    const unsigned G = gridDim.x * gridDim.y * gridDim.z;
    unsigned sum, cnt, mine, sp = 0u;
    for (;;) {
        sum = 0u; cnt = 0u; mine = 0u;
#pragma unroll
        for (unsigned j = 0; j < 16; ++j) { const unsigned c = xb_ld(&bar[XB_XCNT(j)]); sum += c; cnt += (c > 0u) ? 1u : 0u; mine = (j == x) ? c : mine; }
        if (sum == G) break;
        __builtin_amdgcn_s_sleep(1);
        if ((++sp & 255u) == 0u) { if (xb_ld(&bar[XB_TMO])) break; if (sp > XB_SPIN_CAP) { atomicAdd(&bar[XB_TMO], 1u); break; } }
    }
    nloc = mine > 0u ? mine : 1u; nx = cnt > 0u ? cnt : 1u;
}

__device__ __forceinline__ void xcd_barrier(const XcdBarrier& b) {
    asm volatile("s_waitcnt vmcnt(0)" ::: "memory");
    __syncthreads();
    if (threadIdx.x == 0) {
        unsigned* bar = b.bar;
        __builtin_amdgcn_s_waitcnt(0);
        unsigned nloc = b.st[0], nx = b.st[1];
        if (nloc == 0u) { xcd_barrier_complete(bar, b.x, nloc, nx); b.st[0] = nloc; b.st[1] = nx; }
        const unsigned old = xb_add(&bar[XB_XSUB(b.x)], 1u);
        const unsigned gen = old / nloc;
        if (old + 1u == (gen + 1u) * nloc) {
            __builtin_amdgcn_fence(__ATOMIC_RELEASE, "");
            asm volatile("s_waitcnt vmcnt(0)" ::: "memory");
            const unsigned og = xb_add(&bar[XB_TOP], 1u);
            const unsigned tg = og / nx;
            if (og + 1u == (tg + 1u) * nx) xb_add(&bar[XB_TOPGEN], 1u);
            else XB_SPIN(xb_ld(&bar[XB_TOPGEN]) == tg, bar);
            __builtin_amdgcn_fence(__ATOMIC_ACQUIRE, "");
            xb_add(&bar[XB_XGEN(b.x)], 1u);
            asm volatile("s_waitcnt vmcnt(0)" ::: "memory");
        } else {
            XB_SPIN(xb_ld(&bar[XB_XGEN(b.x)]) == gen, bar);
            __builtin_amdgcn_fence(__ATOMIC_ACQUIRE, "");
            asm volatile("s_waitcnt vmcnt(0)" ::: "memory");
        }
    }
    __syncthreads();
}
#include <hip/hip_bf16.h>
#include <cmath>
namespace attn_body {
using bf16=__hip_bfloat16;
using bf16x8=__attribute__((ext_vector_type(8)))short;
using s16x4=__attribute__((ext_vector_type(4)))short;
using f32x16=__attribute__((ext_vector_type(16)))float;
using u32x4=__attribute__((ext_vector_type(4)))unsigned;
constexpr int BATCH=16,NVH=32,SEQ=2048,D=64,DM=1024;
constexpr int NW=8,QBLK=32,QB=QBLK*NW,KVBLK=64,NQB=SEQ/QB;
constexpr int ATTN_PITCH=DM, ATTN_UNIT_ROWS=QB;
__device__ __forceinline__ int crow(int r,int hi){return (r&3)+8*(r>>2)+4*hi;}
#define SBAR() __builtin_amdgcn_sched_barrier(0)
constexpr int BT_N=640;
typedef __attribute__((address_space(3))) const float* lds_fptr;
__device__ __forceinline__ void cmask(f32x16&p0,f32x16&p1,int jb,int qrel,int hi,lds_fptr tb){
  const lds_fptr base=tb+(qrel-64*jb-4*hi+256-59);
  asm volatile("s_waitcnt lgkmcnt(0)\n\ts_nop 7\n\ts_nop 7":"+v"(p0),"+v"(p1)::"memory"); SBAR();
  { float f[16];
    #pragma unroll
    for(int r=0;r<16;++r){const int c=(r&3)+8*(r>>2); f[r]=base[59-c];}
    asm volatile("s_waitcnt lgkmcnt(0)\n\ts_nop 7":"+v"(p0)::"memory"); SBAR();
    #pragma unroll
    for(int r=0;r<16;++r)p0[r]+=f[r];
    asm volatile("s_nop 3":"+v"(p0)::"memory"); SBAR(); }
  { float f[16];
    #pragma unroll
    for(int r=0;r<16;++r){const int c=(r&3)+8*(r>>2); f[r]=base[59-c-32];}
    asm volatile("s_waitcnt lgkmcnt(0)\n\ts_nop 7":"+v"(p1)::"memory"); SBAR();
    #pragma unroll
    for(int r=0;r<16;++r)p1[r]+=f[r];
    asm volatile("s_nop 3":"+v"(p1)::"memory"); SBAR(); }
}

constexpr int NSLOT=3, SLOTB=8192;
constexpr int LDS_K=0, LDS_V=2*NSLOT*SLOTB, LDS_WS=LDS_V+2*NSLOT*SLOTB, LDS_TAB=LDS_WS+NW*64*4, LDS_BYTES=LDS_TAB+640*4;
constexpr float C2=0.125f*1.4426950408889634f;
__device__ __forceinline__ void glds16(const void*gsrc,unsigned lds_dst){unsigned keep;
  asm volatile("s_mov_b32 %0, m0\n\ts_mov_b32 m0, %2\n\ts_nop 0\n\tglobal_load_lds_dwordx4 %1, off\n\ts_mov_b32 m0, %0":"=&s"(keep):"v"(gsrc),"s"(lds_dst):"memory");}
__device__ __forceinline__ float max3f(float a,float b,float c){float r;asm("v_max3_f32 %0, %1, %2, %3":"=v"(r):"v"(a),"v"(b),"v"(c));return r;}
__device__ __forceinline__ float max2f(float a,float b){float r;asm("v_max_f32_e32 %0, %1, %2":"=v"(r):"v"(a),"v"(b));return r;}
__device__ __forceinline__ float fadd_s(float a,float b){float r;asm("v_add_f32_e32 %0, %1, %2":"=v"(r):"v"(a),"v"(b));return r;}
__device__ __forceinline__ float fsub_s(float a,float b){float r;asm("v_sub_f32_e32 %0, %1, %2":"=v"(r):"v"(a),"v"(b));return r;}
typedef float f32x2_t __attribute__((ext_vector_type(2))); typedef __bf16 bf16x2_t __attribute__((ext_vector_type(2)));
__device__ __forceinline__ unsigned cvtpk_s(float lo,float hi){f32x2_t v={lo,hi};bf16x2_t b=__builtin_convertvector(v,bf16x2_t);return __builtin_bit_cast(unsigned,b);}
#define WAIT_BAR(N) asm volatile("s_waitcnt vmcnt(" #N ") lgkmcnt(0)\n\ts_barrier":::"memory")

__device__ __forceinline__ void qkt(f32x16&p0,f32x16&p1,const char*Kslot,const bf16x8*qr,const f32x16&negm,int r32,int hi){
  const char*kb=Kslot+hi*1024+r32*16;
  #pragma unroll
  for(int d0=0;d0<4;++d0){
    const bf16x8 b0=*reinterpret_cast<const bf16x8*>(kb+d0*2048);
    const bf16x8 b1=*reinterpret_cast<const bf16x8*>(kb+d0*2048+512);
    if(d0==0){p0=__builtin_amdgcn_mfma_f32_32x32x16_bf16(b0,qr[0],negm,0,0,0);p1=__builtin_amdgcn_mfma_f32_32x32x16_bf16(b1,qr[0],negm,0,0,0);}
    else{p0=__builtin_amdgcn_mfma_f32_32x32x16_bf16(b0,qr[d0],p0,0,0,0);p1=__builtin_amdgcn_mfma_f32_32x32x16_bf16(b1,qr[d0],p1,0,0,0);}}
}
typedef __attribute__((address_space(3))) const char* lds_cptr;
typedef short v4i16_t __attribute__((ext_vector_type(4)));
__device__ __forceinline__ void kload8(bf16x8*kf,lds_cptr kp){
  kf[0]=*(const __attribute__((address_space(3))) bf16x8*)(kp);      kf[1]=*(const __attribute__((address_space(3))) bf16x8*)(kp+512);
  kf[2]=*(const __attribute__((address_space(3))) bf16x8*)(kp+2048); kf[3]=*(const __attribute__((address_space(3))) bf16x8*)(kp+2560);
  kf[4]=*(const __attribute__((address_space(3))) bf16x8*)(kp+4096); kf[5]=*(const __attribute__((address_space(3))) bf16x8*)(kp+4608);
  kf[6]=*(const __attribute__((address_space(3))) bf16x8*)(kp+6144); kf[7]=*(const __attribute__((address_space(3))) bf16x8*)(kp+6656);
}
__device__ __forceinline__ void kload2(bf16x8*kf,lds_cptr kp,int j){ kf[2*j]=*(const __attribute__((address_space(3))) bf16x8*)(kp+j*2048); kf[2*j+1]=*(const __attribute__((address_space(3))) bf16x8*)(kp+j*2048+512); }
__device__ __forceinline__ s16x4 vtr(lds_cptr p){ return __builtin_bit_cast(s16x4,__builtin_amdgcn_ds_read_tr16_b64_v4i16((__attribute__((address_space(3))) v4i16_t*)p)); }
__device__ __forceinline__ float rowmax(const f32x16&p0,const f32x16&p1){
  float a=max3f(p0[0],p0[1],p1[0]),b=max3f(p0[2],p0[3],p1[1]);a=max3f(a,p1[2],p1[3]);
  #pragma unroll
  for(int r=4;r<16;r+=4){a=max3f(a,p0[r],p0[r+1]);b=max3f(b,p0[r+2],p0[r+3]);a=max3f(a,p1[r],p1[r+1]);b=max3f(b,p1[r+2],p1[r+3]);}
  const float m=max2f(a,b);
  auto rr=__builtin_amdgcn_permlane32_swap(__float_as_uint(m),__float_as_uint(m),false,false);
  return max2f(__uint_as_float(rr[0]),__uint_as_float(rr[1]));
}
#ifndef ATTN_STORE16
#define ATTN_STORE16(p,v) (*(u32x4*)(p)=(v))
#endif
template<int THRL> __device__ __forceinline__ void attn_unit(int b,int h,int qb,const bf16*Q,const bf16*__restrict__ K,const bf16*__restrict__ V,const bf16*__restrict__ GA,bf16*MGo,char*shm,lds_fptr tb,float lam,const float*subw){
  int tid=threadIdx.x; asm volatile("":"+v"(tid)); const int lane=tid&63,r32=lane&31,hi=lane>>5; const int wid=__builtin_amdgcn_readfirstlane(tid>>6), grp=wid>>2, w4=wid&3;
  const long rowbase=(long)b*SEQ; const int q0=qb*128, qcol=h*128+grp*64, vcol=h*128;
  const bf16*Qw=Q+(rowbase+q0+w4*QBLK)*DM+qcol;
  const bf16*Kh=K+rowbase*DM+qcol,*Vh=V+rowbase*DM+vcol;
  const unsigned lds0=(unsigned)(uintptr_t)shm;
  float*wsf=(float*)(shm+LDS_WS)+wid*64;
  const bf16*ksrc=Kh+(long)lane*DM+w4*16;
  const bf16*vsrc=Vh+(long)(16*(wid&3)+(lane>>2))*DM+(wid>>2)*32+(lane&3)*8;
  const unsigned kdst=lds0+LDS_K+grp*(NSLOT*SLOTB)+w4*2048, vdst=lds0+LDS_V+wid*1024;
  #define DMA_K1(t,ks) do{ glds16(ksrc+(long)(t)*KVBLK*DM,(unsigned)__builtin_amdgcn_readfirstlane(kdst+(ks))); glds16(ksrc+(long)(t)*KVBLK*DM+8,(unsigned)__builtin_amdgcn_readfirstlane(kdst+(ks)+1024)); }while(0)
  #define DMA_V2(t,vs) do{ glds16(vsrc+(long)(t)*KVBLK*DM,(unsigned)__builtin_amdgcn_readfirstlane(vdst+(vs))); glds16(vsrc+(long)(t)*KVBLK*DM+64,(unsigned)__builtin_amdgcn_readfirstlane(vdst+(vs)+8192)); }while(0)
  const lds_cptr shm3=(lds_cptr)shm; const lds_cptr vp0=shm3+LDS_V+((lane>>4)&1)*32+(lane&3)*8+(4*hi+((lane&15)>>2))*64;
  const lds_cptr kp0=shm3+LDS_K+grp*(NSLOT*SLOTB)+hi*1024+r32*16;
  const int NT=(q0+128)/KVBLK;
  asm volatile("s_waitcnt vmcnt(0)":::"memory");
  DMA_K1(0,0); DMA_K1(1,SLOTB); DMA_V2(0,0); if(NT>2)DMA_K1(2,2*SLOTB); DMA_V2(1,2*SLOTB);
  bf16x8 qr[4];
  #pragma unroll
  for(int d0=0;d0<4;++d0)qr[d0]=*reinterpret_cast<const bf16x8*>(&Qw[(long)r32*DM+d0*16+hi*8]);
  asm volatile("s_waitcnt vmcnt(0) lgkmcnt(0)\n\ts_barrier":::"memory");
  float mhat=0.f,l_reg=0.f; f32x16 o[4]; o[0]=f32x16{};o[1]=f32x16{};o[2]=f32x16{};o[3]=f32x16{}; f32x16 negm=f32x16{};
  const int qrel=w4*QBLK+r32;
  bool resc=false;
  #define MX3(a,b,c) __builtin_fmaxf(__builtin_fmaxf((a),(b)),(c))
  #define EX(v) __builtin_amdgcn_exp2f(v)
  #define KFR(off) (*(const __attribute__((address_space(3))) bf16x8*)(kp_+(off)))
  #define QKT(P0,P1) do{ P0=__builtin_amdgcn_mfma_f32_32x32x16_bf16(KFR(0),qr[0],negm,0,0,0); P1=__builtin_amdgcn_mfma_f32_32x32x16_bf16(KFR(512),qr[0],negm,0,0,0); \
      P0=__builtin_amdgcn_mfma_f32_32x32x16_bf16(KFR(2048),qr[1],P0,0,0,0); P1=__builtin_amdgcn_mfma_f32_32x32x16_bf16(KFR(2560),qr[1],P1,0,0,0); \
      P0=__builtin_amdgcn_mfma_f32_32x32x16_bf16(KFR(4096),qr[2],P0,0,0,0); P1=__builtin_amdgcn_mfma_f32_32x32x16_bf16(KFR(4608),qr[2],P1,0,0,0); \
      P0=__builtin_amdgcn_mfma_f32_32x32x16_bf16(KFR(6144),qr[3],P0,0,0,0); P1=__builtin_amdgcn_mfma_f32_32x32x16_bf16(KFR(6656),qr[3],P1,0,0,0); }while(0)
  #define DECIDE(P0,P1,RM) do{ resc=false; if(__builtin_expect(__any((RM)>(float)THRL),0)){ const float dl=__builtin_fmaxf((RM),0.f); mhat+=dl; \
        _Pragma("unroll") for(int r=0;r<16;++r){P0[r]-=dl;P1[r]-=dl;} \
        _Pragma("unroll") for(int r=0;r<16;++r)negm[r]=-mhat; \
        const float f=__builtin_amdgcn_exp2f(-dl); l_reg*=f; if(hi==0)wsf[r32]=f; resc=true; } }while(0)
  #define RESC() do{ if(resc){ asm volatile("s_waitcnt lgkmcnt(0)":::"memory"); \
      _Pragma("unroll") for(int d_=0;d_<4;++d_) _Pragma("unroll") for(int r=0;r<16;++r)o[d_][r]*=wsf[crow(r,hi)]; asm volatile("s_waitcnt lgkmcnt(0)":::"memory"); } }while(0)
  #define ROWMAX(P0,P1,RM) do{ float a_=MX3(P0[0],P0[1],P1[0]),b_=MX3(P0[2],P0[3],P1[1]); a_=MX3(a_,P1[2],P1[3]); \
      _Pragma("unroll") for(int r=4;r<16;r+=4){a_=MX3(a_,P0[r],P0[r+1]);b_=MX3(b_,P0[r+2],P0[r+3]);a_=MX3(a_,P1[r],P1[r+1]);b_=MX3(b_,P1[r+2],P1[r+3]);} \
      RM=__builtin_fmaxf(a_,b_); { auto rr=__builtin_amdgcn_permlane32_swap(__float_as_uint(RM),__float_as_uint(RM),false,false); RM=__builtin_fmaxf(__uint_as_float(rr[0]),__uint_as_float(rr[1])); } }while(0)
  #define PACK(P0,P1) do{ pw0=(u32x4){cvtpk_s(P0[0],P0[1]),cvtpk_s(P0[2],P0[3]),cvtpk_s(P0[4],P0[5]),cvtpk_s(P0[6],P0[7])}; pw1=(u32x4){cvtpk_s(P0[8],P0[9]),cvtpk_s(P0[10],P0[11]),cvtpk_s(P0[12],P0[13]),cvtpk_s(P0[14],P0[15])}; \
      pw2=(u32x4){cvtpk_s(P1[0],P1[1]),cvtpk_s(P1[2],P1[3]),cvtpk_s(P1[4],P1[5]),cvtpk_s(P1[6],P1[7])}; pw3=(u32x4){cvtpk_s(P1[8],P1[9]),cvtpk_s(P1[10],P1[11]),cvtpk_s(P1[12],P1[13]),cvtpk_s(P1[14],P1[15])}; }while(0)
  u32x4 pw[4];
  #define pw0 pw[0]
  #define pw1 pw[1]
  #define pw2 pw[2]
  #define pw3 pw[3]
  { const lds_cptr kp_=kp0; f32x16 p0,p1; QKT(p0,p1);
    { const int jb=0-(NT-2); if(jb>=-2)cmask(p0,p1,jb,qrel,hi,tb); }
    float rm; ROWMAX(p0,p1,rm); DECIDE(p0,p1,rm); RESC();
    float sacc=0.f;
    #pragma unroll
    for(int r=0;r<16;++r){p0[r]=EX(p0[r]);p1[r]=EX(p1[r]);sacc+=p0[r]+p1[r];}
    l_reg+=sacc; PACK(p0,p1); }
  int kn=SLOTB,vs=0;
  #define VFRAG(q_,s_) ({ const s16x4 lo_=vtr(vp_+(q_)*4096+(s_)*1024), hi_=vtr(vp_+(q_)*4096+(s_)*1024+512); (bf16x8){lo_[0],lo_[1],lo_[2],lo_[3],hi_[0],hi_[1],hi_[2],hi_[3]}; })
  #define PIN(x) asm volatile("":"+v"(x))
  #define PAW(k) __builtin_bit_cast(bf16x8,pw[k])
  #define FQA(i) ((i)<8?((i)&1):2+((i)&1))
  #define FSA(i) (((i)&7)>>1)
  #define FQB(i) ((i)&3)
  #define FSB(i) ((i)>>2)
  #define GAP3(i,FQ,FS,FILL) do{ if((i)+2<16) vf[((i)+2)%3]=VFRAG(FQ((i)+2),FS((i)+2)); o[FQ(i)]=__builtin_amdgcn_mfma_f32_32x32x16_bf16(PAW(FS(i)),vf[(i)%3],o[FQ(i)],0,0,0); FILL; SBAR(); }while(0)
  for(int t=0;t<NT;++t){
    if(t==0) asm volatile("s_waitcnt lgkmcnt(0)\n\ts_barrier":::"memory");
    else{ if(t+2<NT) asm volatile("s_waitcnt vmcnt(4) lgkmcnt(0)\n\ts_barrier":::"memory"); else if(t+1<NT) asm volatile("s_waitcnt vmcnt(2) lgkmcnt(0)\n\ts_barrier":::"memory"); else asm volatile("s_waitcnt vmcnt(0) lgkmcnt(0)\n\ts_barrier":::"memory"); }
    if(t+3<NT) DMA_K1(t+3,((t+3)%3)*SLOTB);
    if(t+2<NT) DMA_V2(t+2,((t+2)%3)*2*SLOTB);
    const lds_cptr vp_=vp0+vs;
    bf16x8 vf[3];
    if(t+1<NT){
      const lds_cptr kp_=kp0+kn; f32x16 p0,p1;
      bf16x8 kf[8]; SBAR();
      kf[0]=KFR(0);kf[1]=KFR(512);kf[2]=KFR(2048);kf[3]=KFR(2560);kf[4]=KFR(4096);kf[5]=KFR(4608);kf[6]=KFR(6144);kf[7]=KFR(6656); vf[0]=VFRAG(FQA(0),FSA(0)); vf[1]=VFRAG(FQA(1),FSA(1)); SBAR();
      p0=__builtin_amdgcn_mfma_f32_32x32x16_bf16(kf[0],qr[0],negm,0,0,0); p1=__builtin_amdgcn_mfma_f32_32x32x16_bf16(kf[1],qr[0],negm,0,0,0);
      p0=__builtin_amdgcn_mfma_f32_32x32x16_bf16(kf[2],qr[1],p0,0,0,0);   p1=__builtin_amdgcn_mfma_f32_32x32x16_bf16(kf[3],qr[1],p1,0,0,0);
      p0=__builtin_amdgcn_mfma_f32_32x32x16_bf16(kf[4],qr[2],p0,0,0,0);   p1=__builtin_amdgcn_mfma_f32_32x32x16_bf16(kf[5],qr[2],p1,0,0,0);
      p0=__builtin_amdgcn_mfma_f32_32x32x16_bf16(kf[6],qr[3],p0,0,0,0);   p1=__builtin_amdgcn_mfma_f32_32x32x16_bf16(kf[7],qr[3],p1,0,0,0); SBAR();
      GAP3(0,FQA,FSA,);  GAP3(1,FQA,FSA,);  GAP3(2,FQA,FSA,);  GAP3(3,FQA,FSA,);
      { const int jb=t+1-(NT-2); if(jb>=-2)cmask(p0,p1,jb,qrel,hi,tb); }
      float ma,mb,rm;
      GAP3(4,FQA,FSA, ma=MX3(p0[0],p0[1],p1[0]); mb=MX3(p0[2],p0[3],p1[1]); ma=MX3(ma,p1[2],p1[3]); PIN(ma); PIN(mb));
      GAP3(5,FQA,FSA, ma=MX3(ma,p0[4],p0[5]); mb=MX3(mb,p0[6],p0[7]); ma=MX3(ma,p1[4],p1[5]); mb=MX3(mb,p1[6],p1[7]); PIN(ma); PIN(mb));
      GAP3(6,FQA,FSA, ma=MX3(ma,p0[8],p0[9]); mb=MX3(mb,p0[10],p0[11]); ma=MX3(ma,p1[8],p1[9]); mb=MX3(mb,p1[10],p1[11]); PIN(ma); PIN(mb));
      GAP3(7,FQA,FSA, ma=MX3(ma,p0[12],p0[13]); mb=MX3(mb,p0[14],p0[15]); ma=MX3(ma,p1[12],p1[13]); mb=MX3(mb,p1[14],p1[15]); rm=__builtin_fmaxf(ma,mb); PIN(rm));
      { auto rr=__builtin_amdgcn_permlane32_swap(__float_as_uint(rm),__float_as_uint(rm),false,false); rm=__builtin_fmaxf(__uint_as_float(rr[0]),__uint_as_float(rr[1])); }
      DECIDE(p0,p1,rm);
      float sacc=0.f; u32x4 pn0,pn1,pn2,pn3; SBAR();
      #define FILLX(X,B,PN,I) X[B]=EX(X[B]); X[B+1]=EX(X[B+1]); X[B+2]=EX(X[B+2]); X[B+3]=EX(X[B+3]); sacc+=(X[B]+X[B+1])+(X[B+2]+X[B+3]); PN[I]=cvtpk_s(X[B],X[B+1]); PN[I+1]=cvtpk_s(X[B+2],X[B+3]); PIN(PN); PIN(sacc)
      GAP3(8,FQA,FSA, FILLX(p0,0,pn0,0));  GAP3(9,FQA,FSA, FILLX(p0,4,pn0,2));  GAP3(10,FQA,FSA, FILLX(p0,8,pn1,0));  GAP3(11,FQA,FSA, FILLX(p0,12,pn1,2));
      GAP3(12,FQA,FSA, FILLX(p1,0,pn2,0));  GAP3(13,FQA,FSA, FILLX(p1,4,pn2,2));  GAP3(14,FQA,FSA, FILLX(p1,8,pn3,0));  GAP3(15,FQA,FSA, FILLX(p1,12,pn3,2));
      #undef FILLX
      l_reg+=sacc; RESC(); pw0=pn0; pw1=pn1; pw2=pn2; pw3=pn3;
    } else {
      vf[0]=VFRAG(FQB(0),FSB(0)); vf[1]=VFRAG(FQB(1),FSB(1)); SBAR();
      GAP3(0,FQB,FSB,);  GAP3(1,FQB,FSB,);  GAP3(2,FQB,FSB,);  GAP3(3,FQB,FSB,);  GAP3(4,FQB,FSB,);  GAP3(5,FQB,FSB,);  GAP3(6,FQB,FSB,);  GAP3(7,FQB,FSB,);
      GAP3(8,FQB,FSB,);  GAP3(9,FQB,FSB,);  GAP3(10,FQB,FSB,);  GAP3(11,FQB,FSB,);  GAP3(12,FQB,FSB,);  GAP3(13,FQB,FSB,);  GAP3(14,FQB,FSB,);  GAP3(15,FQB,FSB,);
    }
    kn=(kn==2*SLOTB)?0:kn+SLOTB; vs=(vs==4*SLOTB)?0:vs+2*SLOTB;
  }
  #undef GAP3
  #undef FQA
  #undef FSA
  #undef FQB
  #undef FSB
  #undef pw0
  #undef pw1
  #undef pw2
  #undef pw3
  #undef PIN
  #undef PAW
  #undef VFRAG
  #undef PVM
  {auto rr=__builtin_amdgcn_permlane32_swap(__float_as_uint(l_reg),__float_as_uint(l_reg),false,false);l_reg=__uint_as_float(rr[0])+__uint_as_float(rr[1]);}
  if(hi==0)wsf[32+r32]=l_reg;asm volatile("s_waitcnt lgkmcnt(0)":::"memory");
  float rli[16];
  #pragma unroll
  for(int r=0;r<16;++r)rli[r]=__builtin_amdgcn_rcpf(wsf[32+crow(r,hi)]);
  asm volatile("s_waitcnt lgkmcnt(0)\n\ts_barrier":::"memory");
  { bf16*stg=(bf16*)shm+wid*4096;
    #pragma unroll
    for(int r=0;r<16;++r){const int orow=crow(r,hi);
      #pragma unroll
      for(int d0=0;d0<4;++d0)stg[orow*128+d0*32+r32]=__float2bfloat16(o[d0][r]*rli[r]);} }
  asm volatile("s_waitcnt lgkmcnt(0)\n\ts_barrier":::"memory");
  { const int row=16*grp+(lane>>2), c32=(lane&3)*32;
    const bf16*sa=(const bf16*)shm+w4*4096+row*128+c32, *sb=(const bf16*)shm+(4+w4)*4096+row*128+c32;
    const size_t go=(size_t)(rowbase+q0+w4*QBLK+row)*DM+vcol+c32;
    float d[32]; float ss=0.f;
    #pragma unroll
    for(int i=0;i<4;++i){ const u32x4 a1=*(const u32x4*)(sa+8*i), a2=*(const u32x4*)(sb+8*i);
      #pragma unroll
      for(int j=0;j<4;++j){ const unsigned x1=a1[j], x2=a2[j]; const float dl=__uint_as_float(x1<<16)-lam*__uint_as_float(x2<<16), dh=__uint_as_float(x1&0xffff0000u)-lam*__uint_as_float(x2&0xffff0000u);
        d[8*i+2*j]=dl; d[8*i+2*j+1]=dh; ss+=dl*dl+dh*dh; } }
    ss+=__shfl_xor(ss,1); ss+=__shfl_xor(ss,2);
    const float rr_=__builtin_amdgcn_rsqf(ss*(1.0f/128.0f)+1e-5f)*0.8f;
    #pragma unroll
    for(int i=0;i<4;++i){ const u32x4 ga=*(const u32x4*)(GA+go+8*i); const f32x4 s0=*(const f32x4*)(subw+c32+8*i), s1=*(const f32x4*)(subw+c32+8*i+4); u32x4 w;
      #pragma unroll
      for(int j=0;j<4;++j){ const unsigned g=ga[j]; const float gl=__uint_as_float(g<<16), gh=__uint_as_float(g&0xffff0000u);
        const float sl=(j<2)?s0[2*j]:s1[2*j-4], sh=(j<2)?s0[2*j+1]:s1[2*j-3];
        const float ol=__builtin_amdgcn_rcpf(1.0f+__builtin_amdgcn_exp2f(-1.4426950408889634f*gl))*d[8*i+2*j]*rr_*sl, oh=__builtin_amdgcn_rcpf(1.0f+__builtin_amdgcn_exp2f(-1.4426950408889634f*gh))*d[8*i+2*j+1]*rr_*sh;
        w[j]=cvtpk_s(ol,oh); }
      ATTN_STORE16(MGo+go+8*i,w); } }
  asm volatile("s_waitcnt lgkmcnt(0)\n\ts_barrier":::"memory");
  #undef DMA_K1
  #undef DMA_V2
  #undef MX3
  #undef EX
  #undef KFR
  #undef QKT
  #undef DECIDE
  #undef RESC
  #undef ROWMAX
  #undef PACK
}
constexpr int ATTN_LDS_BYTES=LDS_BYTES;
struct AttnTensors { const bf16* Q; const bf16* K; const bf16* V; const bf16* GA; bf16* MG; };
template<int THRL=8> __device__ __forceinline__ void attn_phase(char*lds,const AttnTensors&T,int vcu,lds_fptr tball,float lam,const float*subw){
  const int b=vcu>>4, h=(vcu>>1)&7, half=vcu&1;
  for(int i=0;i<8;++i){ const int pr=i>>1, qb=4*pr+(half?((i&1)?2:1):((i&1)?3:0));
    attn_unit<THRL>(b,h,qb,T.Q,T.K,T.V,T.GA,T.MG,lds,tball,lam,subw); }
}
#undef SBAR
#undef WAIT_BAR
}

constexpr int NWAVES = 8;
constexpr int BATCH = 16, SEQ = 2048, D = 1024, M = BATCH * SEQ, DIN = 6144, DQ2 = 2048, NSEL = 128;
constexpr float C2 = 0.125f * 1.4426950408889634f;
constexpr float LOG2E = 1.4426950408889634f;
constexpr size_t MiB = 1u << 20;
constexpr size_t WS_CTL = 0, CTL_ZERO_BYTES = 1 * MiB;
constexpr size_t WS_MOD = 128 * 1024;
constexpr size_t WS_WIN = 1 * MiB, WS_WOUT = 13 * MiB, WS_WQ = 15 * MiB, WS_WPOOL = 19 * MiB, WS_KEYS = 19 * MiB + 512 * 1024;
constexpr size_t WS_EXP8 = 20 * MiB;
constexpr size_t WS_SCALES = 36 * MiB;
constexpr size_t WS_MODF = 36 * MiB + 256 * 1024;
constexpr size_t WS_XN = 52 * MiB;
constexpr size_t WS_Q = 116 * MiB, WS_K = 180 * MiB, WS_V = 244 * MiB, WS_P = 308 * MiB, WS_GA = 372 * MiB, WS_GP = 436 * MiB, WS_END = 500 * MiB;
constexpr size_t WS_MG = WS_Q;
constexpr size_t WS_SELI = WS_P, WS_SELG = WS_P + 16 * MiB, WS_SELD = WS_P + 32 * MiB;
constexpr size_t WS_Q2 = WS_K;
constexpr int CW_BAR = 4096;
constexpr int RING_BYTES = 131072, LDSCTL_OFF = 153600, MISC_OFF = LDSCTL_OFF + 320, LDS_BYTES = 155648;

struct Frame {
    LAS unsigned char* lds; volatile LAS unsigned* MISC; gu32* ctl;
    int tid, lane, wave, vcu, G;
    const float* in[22]; float* out; unsigned char* ws;
};
__device__ __forceinline__ void refresh(Frame& F) { int t = threadIdx.x; asm volatile("" : "+v"(t)); F.tid = t; F.lane = t & 63; }
typedef int i32x4 __attribute__((ext_vector_type(4)));
__device__ __forceinline__ f32x4 ldmod4(const int* p) { const i32x4 v = *(const i32x4*)p; return (f32x4){(float)v.x, (float)v.y, (float)v.z, (float)v.w} * (1.0f / 16777216.0f); }
__device__ __forceinline__ float wave_sum(float v) {
#pragma unroll
    for (int o = 1; o < 64; o <<= 1) v += __shfl_xor(v, o);
    return v;
}
__device__ __forceinline__ float bflo(unsigned w) { return __builtin_bit_cast(float, w << 16); }
__device__ __forceinline__ float bfhi(unsigned w) { return __builtin_bit_cast(float, w & 0xffff0000u); }
__device__ __forceinline__ float sigm(float x) { return 1.0f / (1.0f + __expf(-x)); }

__device__ __forceinline__ void p0_transpose_item(const float* W, int K, int N, bf16* WT, int row_off, LAS float* scr, int item, int lane, const float* colscale = nullptr) {
    const int nblk = N / 32, kb = item / nblk, nb = item % nblk, k0 = 64 * kb, n0 = 32 * nb;
    const float cs = colscale ? colscale[n0 + (lane & 31)] : 1.0f;
#pragma unroll 8
    for (int i = 0; i < 32; ++i) { const int kk = 2 * i + (lane >> 5); scr[kk * 33 + (lane & 31)] = W[(size_t)(k0 + kk) * N + n0 + (lane & 31)] * cs; }
    LDS_WAIT(); asm volatile("" ::: "memory");
    const int c = lane & 7;
#pragma unroll
    for (int j = 0; j < 4; ++j) { const int n = (lane >> 3) + 8 * j; const LAS float* s = scr + (8 * c) * 33 + n;
        v4u o; o.x = pk2(s[0 * 33], s[1 * 33]); o.y = pk2(s[2 * 33], s[3 * 33]); o.z = pk2(s[4 * 33], s[5 * 33]); o.w = pk2(s[6 * 33], s[7 * 33]);
        *(GAS v4u*)(WT + (size_t)(row_off + n0 + n) * K + k0 + 8 * c) = o; }
    LDS_WAIT(); asm volatile("" ::: "memory");
}
__device__ __forceinline__ void p0_mod_item(Frame& F, int id, LAS float* scr) {
    const int cb = id % 96, kc = id / 96, n = cb * 64 + F.lane;
    const float* c = F.in[1]; const float* wada = F.in[2]; const float* bada = F.in[3];
#pragma unroll 4
    for (int i = 0; i < 32; ++i) { const int e = i * 64 + F.lane, b = e >> 7, k = e & 127; const float cv = c[b * D + kc * 128 + k]; scr[k * 16 + b] = cv / (1.0f + __expf(-cv)); }
    LDS_WAIT(); asm volatile("" ::: "memory");
    float acc[16];
#pragma unroll
    for (int b = 0; b < 16; ++b) acc[b] = 0.f;
#pragma unroll 4
    for (int k = 0; k < 128; ++k) {
        const float w = wada[(size_t)(kc * 128 + k) * DIN + n];
        const f32x4 c0 = *(const LAS f32x4*)(scr + k * 16), c1 = *(const LAS f32x4*)(scr + k * 16 + 4), c2 = *(const LAS f32x4*)(scr + k * 16 + 8), c3 = *(const LAS f32x4*)(scr + k * 16 + 12);
        acc[0] += c0.x * w; acc[1] += c0.y * w; acc[2] += c0.z * w; acc[3] += c0.w * w; acc[4] += c1.x * w; acc[5] += c1.y * w; acc[6] += c1.z * w; acc[7] += c1.w * w;
        acc[8] += c2.x * w; acc[9] += c2.y * w; acc[10] += c2.z * w; acc[11] += c2.w * w; acc[12] += c3.x * w; acc[13] += c3.y * w; acc[14] += c3.z * w; acc[15] += c3.w * w;
    }
    int* mod = (int*)(F.ws + WS_MOD);
    const float bb = (kc == 0) ? bada[n] : 0.f;
#pragma unroll
    for (int b = 0; b < 16; ++b) atomicAdd(mod + b * DIN + n, (int)rintf((acc[b] + bb) * 16777216.0f));
    LDS_WAIT(); asm volatile("" ::: "memory");
}
__device__ __forceinline__ void p0_quant_expert(Frame& F, int e) {
    const int lane = F.lane;
    const GAS f32x4* sd = (const GAS f32x4*)(F.in[19] + (size_t)e * D) + 4 * lane;
    const GAS f32x4* su = (const GAS f32x4*)(F.in[20] + (size_t)e * D) + 4 * lane;
    f32x4 vd[4], vu[4]; float ssd = 0.f, ssu = 0.f;
#pragma unroll
    for (int j = 0; j < 4; ++j) { vd[j] = sd[j]; vu[j] = su[j]; }
#pragma unroll
    for (int j = 0; j < 4; ++j) { ssd += (vd[j].x * vd[j].x + vd[j].y * vd[j].y) + (vd[j].z * vd[j].z + vd[j].w * vd[j].w); ssu += (vu[j].x * vu[j].x + vu[j].y * vu[j].y) + (vu[j].z * vu[j].z + vu[j].w * vu[j].w); }
#pragma unroll
    for (int o = 1; o < 64; o <<= 1) { ssd += __shfl_xor(ssd, o); ssu += __shfl_xor(ssu, o); }
    const float stepd = fmaxf(0.3352f * sqrtf(ssd * (1.f / D)), 1e-30f), stepu = fmaxf(0.48f * sqrtf(ssu * (1.f / D)), 1e-30f), invd = 1.0f / stepd, invu = 1.0f / stepu;
    v4u w;
#pragma unroll
    for (int k = 0; k < 2; ++k) { unsigned ad = 0u, au = 0u;
#pragma unroll
        for (int j = 0; j < 8; ++j) {
            { const float x = vd[2 * k + (j >> 2)][j & 3] * invd; int u = (int)floorf(x) + 8; u = u < 0 ? 0 : (u > 15 ? 15 : u); ad |= ((unsigned)u ^ 8u) << (4 * j); }
            { const float x = vu[2 * k + (j >> 2)][j & 3] * invu, a = fabsf(x);
              unsigned code = (a < 0.25f) ? 0u : (a < 0.75f) ? 1u : (a < 1.25f) ? 2u : (a < 1.75f) ? 3u : (a < 2.5f) ? 4u : (a < 3.5f) ? 5u : (a < 5.0f) ? 6u : 7u; if (x < 0.f) code |= 8u; au |= code << (4 * j); } }
        if (k == 0) { w.x = ad; w.z = au; } else { w.y = ad; w.w = au; } }
    *(GAS v4u*)(F.ws + WS_EXP8 + (size_t)e * 1024 + 16 * lane) = w;
    if (lane == 0) { ((float*)(F.ws + WS_SCALES))[2 * e] = stepd; ((float*)(F.ws + WS_SCALES))[2 * e + 1] = stepu; }
}
__device__ __forceinline__ void p0a_prologue(Frame& F) {
    LAS float* scr = (LAS float*)(F.lds + F.wave * 16384);
    const int gw = F.vcu * NWAVES + F.wave, NGW = F.G * NWAVES;
    constexpr int I_MOD = 768, I_IN = (D / 64) * (DIN / 32), I_OUT = (D / 64) * (D / 32), I_WQ = (D / 64) * (DQ2 / 32), I_PW = (256 / 64) * (256 / 32), I_KEYS = 2 * 131072 / 512;
    constexpr int I_EXP = 16384;
    constexpr int NITEMS = I_MOD + I_IN + I_OUT + I_WQ + 4 * I_PW + I_KEYS + I_EXP;
    for (int it = gw; it < NITEMS; it += NGW) {
        int r = it;
        if (r < I_MOD) { p0_mod_item(F, r, scr); continue; } r -= I_MOD;
        if (r < I_IN) { p0_transpose_item(F.in[5], D, DIN, (bf16*)(F.ws + WS_WIN), 0, scr, r, F.lane); continue; } r -= I_IN;
        if (r < I_OUT) { p0_transpose_item(F.in[14], D, D, (bf16*)(F.ws + WS_WOUT), 0, scr, r, F.lane); continue; } r -= I_OUT;
        if (r < I_WQ) { p0_transpose_item(F.in[16], D, DQ2, (bf16*)(F.ws + WS_WQ), 0, scr, r, F.lane); continue; } r -= I_WQ;
        if (r < 4 * I_PW) { const int g = r / I_PW; p0_transpose_item(F.in[12] + (size_t)g * 65536, 256, 256, (bf16*)(F.ws + WS_WPOOL) + (size_t)g * 65536, 0, scr, r % I_PW, F.lane, F.in[13] + g * 256); continue; } r -= 4 * I_PW;
        if (r >= I_KEYS) { p0_quant_expert(F, r - I_KEYS); continue; }
        { const int e0 = r * 512 + F.lane * 8; const float* src = (e0 < 131072) ? (F.in[17] + e0) : (F.in[18] + (e0 - 131072));
          const f32x4 a = *(const f32x4*)src, b = *(const f32x4*)(src + 4);
          v4u o; o.x = pk2(a[0], a[1]); o.y = pk2(a[2], a[3]); o.z = pk2(b[0], b[1]); o.w = pk2(b[2], b[3]);
          const int hh = e0 >> 14, key = (e0 >> 7) & 127, d0 = e0 & 127;
          *(GAS v4u*)((bf16*)(F.ws + WS_KEYS) + (((hh * 4 + (key >> 5)) * 8 + (d0 >> 4)) * 512 + (((d0 >> 3) & 1) * 32 + (key & 31)) * 8)) = o; }
    }
}
__device__ __forceinline__ f32x4 ld4bf(const bf16* p) { const unsigned long long w = *(const unsigned long long*)p; const unsigned lo = (unsigned)w, hi = (unsigned)(w >> 32); return (f32x4){bflo(lo), bfhi(lo), bflo(hi), bfhi(hi)}; }
template <bool SRC_BF16> __device__ __forceinline__ void norm_mod_rows_t(Frame& F, const void* srcv, const float* nw, int sh_off, int sc_off, bf16* dst, float eps) {
    const int gw = F.vcu * NWAVES + F.wave, NGW = F.G * NWAVES;
    const float* mod = (const float*)(F.ws + WS_MODF);
    for (int m0 = gw; m0 < M; m0 += 2 * NGW) {
        const int m1 = m0 + NGW;
        f32x4 v0[4], v1[4]; float s0 = 0.f, s1 = 0.f;
#pragma unroll
        for (int j = 0; j < 4; ++j) {
            if (SRC_BF16) { v0[j] = ld4bf((const bf16*)srcv + (size_t)m0 * D + 4 * F.lane + 256 * j); v1[j] = ld4bf((const bf16*)srcv + (size_t)m1 * D + 4 * F.lane + 256 * j); }
            else { v0[j] = *((const GAS f32x4*)((const float*)srcv + (size_t)m0 * D) + F.lane + 64 * j); v1[j] = *((const GAS f32x4*)((const float*)srcv + (size_t)m1 * D) + F.lane + 64 * j); } }
#pragma unroll
        for (int j = 0; j < 4; ++j) { s0 += (v0[j].x * v0[j].x + v0[j].y * v0[j].y) + (v0[j].z * v0[j].z + v0[j].w * v0[j].w); s1 += (v1[j].x * v1[j].x + v1[j].y * v1[j].y) + (v1[j].z * v1[j].z + v1[j].w * v1[j].w); }
#pragma unroll
        for (int o = 1; o < 64; o <<= 1) { s0 += __shfl_xor(s0, o); s1 += __shfl_xor(s1, o); }
        const float r0 = 1.0f / sqrtf(s0 * (1.f / D) + eps), r1 = 1.0f / sqrtf(s1 * (1.f / D) + eps);
        const int b0 = m0 >> 11, b1 = m1 >> 11;
        GAS unsigned long long* o0 = (GAS unsigned long long*)(dst + (size_t)m0 * D) + F.lane; GAS unsigned long long* o1 = (GAS unsigned long long*)(dst + (size_t)m1 * D) + F.lane;
#pragma unroll
        for (int j = 0; j < 4; ++j) { const int col = 4 * F.lane + 256 * j; const f32x4 w = *(const f32x4*)(nw + col);
            { const f32x4 sc = *(const f32x4*)(mod + b0 * DIN + sc_off + col), sh = *(const f32x4*)(mod + b0 * DIN + sh_off + col); const f32x4 hq = v0[j] * r0 * w * (sc + 1.0f) + sh;
              o0[64 * j] = (unsigned long long)pk2(hq.x, hq.y) | ((unsigned long long)pk2(hq.z, hq.w) << 32); }
            { const f32x4 sc = *(const f32x4*)(mod + b1 * DIN + sc_off + col), sh = *(const f32x4*)(mod + b1 * DIN + sh_off + col); const f32x4 hq = v1[j] * r1 * w * (sc + 1.0f) + sh;
              o1[64 * j] = (unsigned long long)pk2(hq.x, hq.y) | ((unsigned long long)pk2(hq.z, hq.w) << 32); } }
    }
}
__device__ __forceinline__ void p0b_rows(Frame& F, bf16* dst) {
    LAS float* ms = (LAS float*)F.lds;
    const int b = F.vcu >> 4; int* mi = (int*)(F.ws + WS_MOD) + b * DIN; float* mf = (float*)(F.ws + WS_MODF) + b * DIN;
    for (int i = F.tid; i < 2048; i += NWAVES * 64) ms[i] = (float)__hip_atomic_fetch_add(mi + i, 0, __ATOMIC_RELAXED, __HIP_MEMORY_SCOPE_AGENT) * (1.0f / 16777216.0f);
    { const int seg = (F.vcu & 15) * 384; if (F.tid < 384) mf[seg + F.tid] = (float)__hip_atomic_fetch_add(mi + seg + F.tid, 0, __ATOMIC_RELAXED, __HIP_MEMORY_SCOPE_AGENT) * (1.0f / 16777216.0f); }
    __syncthreads();
    const float* src = F.in[0]; const float* nw = F.in[4];
#pragma unroll 1
    for (int k = 0; k < 16; k += 2) {
        const int m0 = F.vcu * 128 + F.wave + 8 * k, m1 = m0 + 8;
        f32x4 v0[4], v1[4]; float s0 = 0.f, s1 = 0.f;
#pragma unroll
        for (int j = 0; j < 4; ++j) { v0[j] = *((const GAS f32x4*)(src + (size_t)m0 * D) + F.lane + 64 * j); v1[j] = *((const GAS f32x4*)(src + (size_t)m1 * D) + F.lane + 64 * j); }
#pragma unroll
        for (int j = 0; j < 4; ++j) { s0 += (v0[j].x * v0[j].x + v0[j].y * v0[j].y) + (v0[j].z * v0[j].z + v0[j].w * v0[j].w); s1 += (v1[j].x * v1[j].x + v1[j].y * v1[j].y) + (v1[j].z * v1[j].z + v1[j].w * v1[j].w); }
#pragma unroll
        for (int o = 1; o < 64; o <<= 1) { s0 += __shfl_xor(s0, o); s1 += __shfl_xor(s1, o); }
        const float r0 = 1.0f / sqrtf(s0 * (1.f / D) + 1e-6f), r1 = 1.0f / sqrtf(s1 * (1.f / D) + 1e-6f);
        GAS unsigned long long* o0 = (GAS unsigned long long*)(dst + (size_t)m0 * D) + F.lane; GAS unsigned long long* o1 = (GAS unsigned long long*)(dst + (size_t)m1 * D) + F.lane;
#pragma unroll
        for (int j = 0; j < 4; ++j) { const int col = 4 * F.lane + 256 * j; const f32x4 w = *(const f32x4*)(nw + col);
            const f32x4 sh = *(const LAS f32x4*)(ms + col), sc = *(const LAS f32x4*)(ms + 1024 + col);
            { const f32x4 hq = v0[j] * r0 * w * (sc + 1.0f) + sh; o0[64 * j] = (unsigned long long)pk2(hq.x, hq.y) | ((unsigned long long)pk2(hq.z, hq.w) << 32); }
            { const f32x4 hq = v1[j] * r1 * w * (sc + 1.0f) + sh; o1[64 * j] = (unsigned long long)pk2(hq.x, hq.y) | ((unsigned long long)pk2(hq.z, hq.w) << 32); } }
    }
}
__device__ __forceinline__ void fill_bias_table2(Frame& F, LAS float* tb, int h) {
    const float* rb = F.in[11];
    for (int i = F.tid; i < 640; i += NWAVES * 64) { const int dist = i - 256;
        float v;
        if (dist < 0) v = -INFINITY; else if (dist >= 128) v = 0.f;
        else { int bk = dist; if (dist >= 16) { bk = 16 + (int)(log2f((float)dist * (1.f / 16.f)) * (16.f / 3.f)); if (bk > 31) bk = 31; } v = (rb[bk * 8 + h] - rb[31 * 8 + h]) * LOG2E; }
        tb[i] = v; }
}
template <int W> __device__ __forceinline__ void pool_item(const bf16* __restrict__ P, bf16* __restrict__ PO, int b, int chunk, int g, int lane) {
    const int t0 = chunk * 64, col = g * 256 + lane * 4; const size_t rowb = (size_t)b * SEQ;
    f32x4 ring[16], nw[16];
#pragma unroll
    for (int i = 0; i < 16; ++i) { const int t = t0 - 16 + i; ring[i] = (t >= 0) ? ld4bf(P + (rowb + t) * D + col) : (f32x4){0.f, 0.f, 0.f, 0.f}; }
    for (int blk = 0; blk < 4; ++blk) {
#pragma unroll
        for (int i = 0; i < 16; ++i) nw[i] = ld4bf(P + (rowb + t0 + blk * 16 + i) * D + col);
#pragma unroll
        for (int i = 0; i < 16; ++i) { const int t = t0 + blk * 16 + i;
            f32x4 s = nw[i];
#pragma unroll
            for (int j = 1; j < W; ++j) s += (i - j >= 0) ? nw[i - j] : ring[16 + i - j];
            const int cnt = (t + 1 < W) ? (t + 1) : W;
            const f32x4 r = s * (1.0f / (float)cnt) - nw[i];
            *(unsigned long long*)(PO + (rowb + t) * D + col) = (unsigned long long)pk2(r.x, r.y) | ((unsigned long long)pk2(r.z, r.w) << 32); }
#pragma unroll
        for (int i = 0; i < 16; ++i) ring[i] = nw[i];
    }
}
typedef short rbf16x8 __attribute__((ext_vector_type(8)));
typedef float rf32x16 __attribute__((ext_vector_type(16)));
__device__ __forceinline__ void ce_desc(float& a, float& b) { const float hi = __builtin_fmaxf(a, b), lo = __builtin_fminf(a, b); a = hi; b = lo; }
__device__ __forceinline__ void bitonic_merge16_desc(float (&v)[16]) {
#pragma unroll
    for (int j = 8; j > 0; j >>= 1)
#pragma unroll
        for (int i = 0; i < 16; ++i) { const int l = i ^ j; if (l > i) ce_desc(v[i], v[l]); }
}
__device__ __forceinline__ void sort16_desc(float (&v)[16]) {
#pragma unroll
    for (int k = 2; k <= 16; k <<= 1)
#pragma unroll
        for (int j = k >> 1; j > 0; j >>= 1)
#pragma unroll
            for (int i = 0; i < 16; ++i) { const int l = i ^ j; if (l > i) { if ((i & k) == 0) ce_desc(v[i], v[l]); else ce_desc(v[l], v[i]); } }
}
__device__ __forceinline__ void merge_top16(float (&a)[16], const float (&b)[16]) {
#pragma unroll
    for (int i = 0; i < 16; ++i) a[i] = __builtin_fmaxf(a[i], b[15 - i]);
    bitonic_merge16_desc(a);
}
__device__ __forceinline__ float pack_idx(float s, unsigned keepmask, unsigned idx) { return __builtin_bit_cast(float, (__builtin_bit_cast(unsigned, s) & keepmask) | idx); }
__device__ __forceinline__ void fold_block(const rf32x16& acc, int blk, int hi, float (&top)[16]) {
    if (blk == 0) {
#pragma unroll
        for (int r = 0; r < 16; ++r) top[r] = pack_idx(acc[r], 0xFFFFFF80u, (unsigned)((r & 3) + 8 * (r >> 2)) + 4u * (unsigned)hi);
        sort16_desc(top);
    } else {
        float g[16];
#pragma unroll
        for (int r = 0; r < 16; ++r) g[r] = pack_idx(acc[r], 0xFFFFFF80u, (unsigned)(32 * blk + (r & 3) + 8 * (r >> 2)) + 4u * (unsigned)hi);
        sort16_desc(g); merge_top16(top, g);
    }
}
__device__ __forceinline__ void merge_pair(float (&top)[16], int hi) {
    float o[16];
#pragma unroll
    for (int i = 0; i < 16; ++i) { const unsigned u = __builtin_bit_cast(unsigned, top[i]); auto rr = __builtin_amdgcn_permlane32_swap(u, u, false, false); o[i] = __builtin_bit_cast(float, hi ? rr[0] : rr[1]); }
    merge_top16(top, o);
}
typedef float f32x2g __attribute__((ext_vector_type(2)));
__host__ __device__ constexpr int cand_pos(int i, int j) { int p = 0; for (int a = 0; a < 16; ++a) for (int b = 0; b < 16; ++b) { if (a == i && b == j) return p; if ((a + 1) * (b + 1) <= 16) ++p; } return p; }
static_assert(cand_pos(15, 0) == 49, "50 candidate pairs");
__device__ __forceinline__ void retrieval_mfma(Frame& F, const bf16* Q2, const bf16* KEYS, int* SELI, float* SELG, int tt0, int tt1) {
    const int h = F.wave;
    const __amdgpu_buffer_rsrc_t rq = __builtin_amdgcn_make_buffer_rsrc((void*)Q2, (short)0, M * DQ2 * 2, 0x00020000);
    const __amdgpu_buffer_rsrc_t rk = __builtin_amdgcn_make_buffer_rsrc((void*)KEYS, (short)0, 2 * 8 * 128 * 128 * 2, 0x00020000);
#pragma unroll 1
    for (int tt = tt0; tt < tt1; ++tt) {
        const int T0 = F.vcu * 128 + tt * 32;
        int lane = F.lane; asm volatile("" : "+v"(lane));
        const int r32 = lane & 31, hi = lane >> 5;
        float v1[16], v2[16];
#pragma unroll
        for (int half = 0; half < 2; ++half) {
            const int qoff = (((T0 >> 5) * 8 + h) * 2 + half) * 8192 + lane * 16;
            const int koff = lane * 16, ksoff = (half * 8 + h) * 128 * 128 * 2;
            rbf16x8 bq[8];
#pragma unroll
            for (int ks = 0; ks < 8; ++ks) bq[ks] = __builtin_bit_cast(rbf16x8, __builtin_amdgcn_raw_buffer_load_b128(rq, qoff + ks * 1024, 0, 0));
            rbf16x8 ak[2][8];
#pragma unroll
            for (int ks = 0; ks < 8; ++ks) ak[0][ks] = __builtin_bit_cast(rbf16x8, __builtin_amdgcn_raw_buffer_load_b128(rk, koff + ks * 1024, ksoff, 0));
#pragma unroll
            for (int blk = 0; blk < 4; ++blk) {
                if (blk < 3) {
#pragma unroll
                    for (int ks = 0; ks < 8; ++ks) ak[(blk + 1) & 1][ks] = __builtin_bit_cast(rbf16x8, __builtin_amdgcn_raw_buffer_load_b128(rk, koff + (blk + 1) * 8192 + ks * 1024, ksoff, 0));
                }
                rf32x16 acc = (rf32x16){0.f, 0.f, 0.f, 0.f, 0.f, 0.f, 0.f, 0.f, 0.f, 0.f, 0.f, 0.f, 0.f, 0.f, 0.f, 0.f};
#pragma unroll
                for (int ks = 0; ks < 8; ++ks) acc = __builtin_amdgcn_mfma_f32_32x32x16_bf16(ak[blk & 1][ks], bq[ks], acc, 0, 0, 0);
                if (half == 0) fold_block(acc, blk, hi, v1); else fold_block(acc, blk, hi, v2);
                asm volatile("" ::: "memory");
            }
            if (half == 0) merge_pair(v1, hi); else merge_pair(v2, hi);
        }
        float c0[16], c1[16], c2[16], c3[16];
#pragma unroll
        for (int i = 0; i < 16; ++i)
#pragma unroll
            for (int j = 0; j < 16; ++j) if ((i + 1) * (j + 1) <= 16) {
                const int p = cand_pos(i, j);
                const unsigned e = ((__builtin_bit_cast(unsigned, v1[i]) & 0x7Fu) << 7) | (__builtin_bit_cast(unsigned, v2[j]) & 0x7Fu);
                const float sv = pack_idx(v1[i] + v2[j], 0xFFFFC000u, e);
                if (p < 16) c0[p & 15] = sv; else if (p < 32) c1[p & 15] = sv; else if (p < 48) c2[p & 15] = sv; else c3[p & 15] = sv; }
#pragma unroll
        for (int q = 2; q < 16; ++q) c3[q] = -INFINITY;
        sort16_desc(c0); sort16_desc(c1); sort16_desc(c2); sort16_desc(c3);
        merge_top16(c0, c1); merge_top16(c2, c3); merge_top16(c0, c2);
        float ev[16]; float sum = 0.f;
#pragma unroll
        for (int k = 0; k < 16; ++k) { ev[k] = __expf(c0[k] - c0[0]); sum += ev[k]; }
        const float inv = 1.0f / sum;
        const size_t o = (size_t)(T0 + r32) * NSEL + h * 16;
        const float* SC = (const float*)(F.ws + WS_SCALES); float* SELD = (float*)(F.ws + WS_SELD);
        { unsigned e8[8]; float g8[8];
#pragma unroll
          for (int k = 0; k < 8; ++k) { e8[k] = __builtin_bit_cast(unsigned, hi ? c0[8 + k] : c0[k]) & 0x3FFFu; g8[k] = (hi ? ev[8 + k] : ev[k]) * inv; }
          f32x2g sc[8];
#pragma unroll
          for (int k = 0; k < 8; ++k) sc[k] = *(const f32x2g*)(SC + 2 * e8[k]);
          const size_t o8 = o + 8 * hi;
          *(v4u*)(SELI + o8) = (v4u){e8[0], e8[1], e8[2], e8[3]}; *(v4u*)(SELI + o8 + 4) = (v4u){e8[4], e8[5], e8[6], e8[7]};
          *(f32x4*)(SELD + o8) = (f32x4){sc[0].x, sc[1].x, sc[2].x, sc[3].x}; *(f32x4*)(SELD + o8 + 4) = (f32x4){sc[4].x, sc[5].x, sc[6].x, sc[7].x};
          *(f32x4*)(SELG + o8) = (f32x4){g8[0] * sc[0].y, g8[1] * sc[1].y, g8[2] * sc[2].y, g8[3] * sc[3].y}; *(f32x4*)(SELG + o8 + 4) = (f32x4){g8[4] * sc[4].y, g8[5] * sc[5].y, g8[6] * sc[6].y, g8[7] * sc[7].y}; }
    }
}
__device__ __forceinline__ float ub0(unsigned w) { return (float)(w & 0xffu); }
__device__ __forceinline__ float ub1(unsigned w) { return (float)((w >> 8) & 0xffu); }
__device__ __forceinline__ float ub2(unsigned w) { return (float)((w >> 16) & 0xffu); }
__device__ __forceinline__ float ub3(unsigned w) { return (float)(w >> 24); }
__device__ __forceinline__ float gelu1(float v) {
    const float av = fabsf(v), t = __builtin_amdgcn_rcpf(av * 0.2316418882f + 1.0f);
    float q = t * 0.5307027145f + (-0.7265760135f); q = q * t + 0.7107068705f; q = q * t + (-0.142248368f); q = q * t + 0.127414796f; q = q * t;
    const float e = __builtin_amdgcn_exp2f((v * v) * (-0.72134752044f)), m = v * (q * e);
    return v < 0.f ? m : v - m;
}
__device__ __forceinline__ int xch32(int v, int lane) { auto rr = __builtin_amdgcn_permlane32_swap((unsigned)v, (unsigned)v, false, false); return (int)((lane & 32) ? rr[0] : rr[1]); }
__device__ __forceinline__ int xch16(int v, int lane) { auto rr = __builtin_amdgcn_permlane16_swap((unsigned)v, (unsigned)v, false, false); return (int)((lane & 16) ? rr[0] : rr[1]); }
__device__ __forceinline__ int xch8(int v) { return __builtin_amdgcn_update_dpp(0, v, 0x128, 0xf, 0xf, false); }
__device__ __forceinline__ int red8i(int v) { v += __builtin_amdgcn_update_dpp(0, v, 0x141, 0xf, 0xf, false);
    v += __builtin_amdgcn_update_dpp(0, v, 0x4E, 0xf, 0xf, false); v += __builtin_amdgcn_update_dpp(0, v, 0xB1, 0xf, 0xf, false); return v; }
typedef unsigned u32x2g __attribute__((ext_vector_type(2)));
typedef int v8i32_t __attribute__((ext_vector_type(8)));
#define PEER4_COMPUTE(c, RB, GG, DD) do { int p[8]; \
        _Pragma("unroll") for (int i = 0; i < 8; ++i) { const int w0 = (int)RB[i].x, w1 = (int)RB[i].y; int dh, dl; \
            asm("v_dot8_i32_i4 %0, %1, %2, 0" : "=v"(dh) : "v"(w0), "v"(hA0)); asm("v_dot8_i32_i4 %0, %1, %2, %0" : "+v"(dh) : "v"(w1), "v"(hA1)); \
            asm("v_dot8_i32_i4 %0, %1, %2, 0" : "=v"(dl) : "v"(w0), "v"(hB0)); asm("v_dot8_i32_i4 %0, %1, %2, %0" : "+v"(dl) : "v"(w1), "v"(hB1)); p[i] = (dh << 4) + dl; } \
          \
        int q4[4], q2[2], q1; \
        _Pragma("unroll") for (int i = 0; i < 4; ++i) { auto r_ = __builtin_amdgcn_permlane32_swap((unsigned)p[i], (unsigned)p[4 + i], false, false); q4[i] = (int)(r_[0] + r_[1]); } \
        _Pragma("unroll") for (int i = 0; i < 2; ++i) { auto r_ = __builtin_amdgcn_permlane16_swap((unsigned)q4[i], (unsigned)q4[2 + i], false, false); q2[i] = (int)(r_[0] + r_[1]); } \
        { const int keep = (lane & 8) ? q2[1] : q2[0], send = (lane & 8) ? q2[0] : q2[1]; q1 = keep + xch8(send); } \
        q1 = red8i(q1); \
        const float wv = GG * gelu1(DD * hscale * ((float)q1 - hoff));     \
        const float ws_ = __builtin_amdgcn_fmed3f(wv * 512.0f, -448.0f, 448.0f); \
        const int wq_ = __builtin_amdgcn_cvt_pk_fp8_f32(ws_, ws_, 0, false); \
        _Pragma("unroll") for (int i = 0; i < 8; i += 2) { \
            const unsigned ci = ((unsigned)__builtin_amdgcn_ds_bpermute(abp_ + 32 * i, wq_) & 0xffu) << ash;     \
            v8i32_t av_; av_[0] = am0 ? (int)ci : 0; av_[1] = am1 ? (int)ci : 0; av_[2] = am2 ? (int)ci : 0; av_[3] = am3 ? (int)ci : 0; av_[4] = am4 ? (int)ci : 0; av_[5] = am5 ? (int)ci : 0; av_[6] = am6 ? (int)ci : 0; av_[7] = am7 ? (int)ci : 0; \
            const v8i32_t bv_ = (v8i32_t){(int)RB[i].z, (int)RB[i].w, (int)RB[i + 1].z, (int)RB[i + 1].w, 0, 0, 0, 0}; \
            acc = __builtin_amdgcn_mfma_scale_f32_32x32x64_f8f6f4(av_, bv_, acc, 0  , 4  , 0, 118  , 0, 127); } } while (0)
#define PEERS_LOAD(tok, cc, EA, EB, RB, GG, DD) do { const int cc_ = (cc); const size_t so_ = (size_t)(tok) * NSEL + cc_ * 8 + isel; GG = SELG[so_]; DD = SELD[so_]; \
        const int Ec_ = (cc_ < 8) ? (EA) : (EB); const int sb_ = (cc_ & 7) * 8; \
        _Pragma("unroll") for (int i = 0; i < 8; ++i) { const int e = __builtin_amdgcn_readlane(Ec_, sb_ + i); \
        const v4u rw = __builtin_bit_cast(v4u, __builtin_amdgcn_raw_buffer_load_b128(rexp, 16 * lane, e * 1024, 0)); RB[i] = rw; } } while (0)
#define PEERS_PROLOGUE() do { float h[16]; \
        { const v4u w0 = hr0, w1 = hr1; \
          h[0] = bflo(w0.x); h[1] = bfhi(w0.x); h[2] = bflo(w0.y); h[3] = bfhi(w0.y); h[4] = bflo(w0.z); h[5] = bfhi(w0.z); h[6] = bflo(w0.w); h[7] = bfhi(w0.w); \
          h[8] = bflo(w1.x); h[9] = bfhi(w1.x); h[10] = bflo(w1.y); h[11] = bfhi(w1.y); h[12] = bflo(w1.z); h[13] = bfhi(w1.z); h[14] = bflo(w1.w); h[15] = bfhi(w1.w); } \
        float am = 0.f; \
        _Pragma("unroll") for (int i = 0; i < 16; ++i) am = fmaxf(am, fabsf(h[i])); \
        _Pragma("unroll") for (int i = 0; i < 16; ++i) acc[i] = 0.f; \
        _Pragma("unroll") for (int o = 1; o < 64; o <<= 1) am = fmaxf(am, __shfl_xor(am, o)); \
        am = fmaxf(am, 1e-30f); \
        const float hinv = 119.0f / am; hscale = am * (1.0f / 119.0f); \
          \
          \
        int hsum = 0; hA0 = 0u; hA1 = 0u; hB0 = 0u; hB1 = 0u; \
        _Pragma("unroll") for (int i = 0; i < 16; ++i) { const int hq = (int)rintf(h[i] * hinv); hsum += hq; const int bd = ((hq + 8) & 15) - 8, ad = (hq - bd) >> 4; \
            if (i < 8) { hA0 |= (unsigned)(ad & 15) << (4 * i); hB0 |= (unsigned)(bd & 15) << (4 * i); } else { hA1 |= (unsigned)(ad & 15) << (4 * (i - 8)); hB1 |= (unsigned)(bd & 15) << (4 * (i - 8)); } } \
        _Pragma("unroll") for (int o = 1; o < 64; o <<= 1) hsum += __shfl_xor(hsum, o); \
        hoff = -0.5f * (float)hsum;                   \
          \
        xr0 = *(const v4u*)(X1 + (size_t)t * D + 16 * lane); xr1 = *(const v4u*)(X1 + (size_t)t * D + 16 * lane + 8); \
        if (t + NWAVES < tend) { const int tn_ = t + NWAVES; En0 = SELI[(size_t)tn_ * NSEL + lane]; En1 = SELI[(size_t)tn_ * NSEL + 64 + lane]; \
            hr0 = *(const v4u*)(H2 + (size_t)tn_ * D + 16 * lane); hr1 = *(const v4u*)(H2 + (size_t)tn_ * D + 16 * lane + 8); } } while (0)
#define PEERS_EPILOGUE() do { float x2[16]; float ss = 0.f; \
        _Pragma("unroll") for (int j = 0; j < 4; ++j) { const int col = 16 * lane + 4 * j; const unsigned wlo = (j < 2) ? (j == 0 ? xr0.x : xr0.z) : (j == 2 ? xr1.x : xr1.z), whi = (j < 2) ? (j == 0 ? xr0.y : xr0.w) : (j == 2 ? xr1.y : xr1.w); \
            const f32x4 xv = (f32x4){bflo(wlo), bfhi(wlo), bflo(whi), bfhi(whi)}, g2 = *(const LAS f32x4*)(g2s + col); \
            x2[4 * j] = xv.x + g2.x * acc[4 * j]; x2[4 * j + 1] = xv.y + g2.y * acc[4 * j + 1]; x2[4 * j + 2] = xv.z + g2.z * acc[4 * j + 2]; x2[4 * j + 3] = xv.w + g2.w * acc[4 * j + 3]; \
            ss += (x2[4 * j] * x2[4 * j] + x2[4 * j + 1] * x2[4 * j + 1]) + (x2[4 * j + 2] * x2[4 * j + 2] + x2[4 * j + 3] * x2[4 * j + 3]); } \
        const float rr = 1.0f / sqrtf(wave_sum(ss) * (1.f / D) + 1e-6f); \
        _Pragma("unroll") for (int j = 0; j < 4; ++j) { const int col = 16 * lane + 4 * j; const f32x4 w = *(const LAS f32x4*)(nfws + col); \
            *(f32x4*)(OUT + (size_t)t * D + col) = (f32x4){x2[4 * j] * rr * w.x, x2[4 * j + 1] * rr * w.y, x2[4 * j + 2] * rr * w.z, x2[4 * j + 3] * rr * w.w}; } } while (0)
#define PEERS_SLOT(CRB, CG, CD, LRB, LG, LD) do { \
        if ((n & 15) == 0) { if (n > 0) { PEERS_EPILOGUE(); t += NWAVES; E0 = En0; E1 = En1; } PEERS_PROLOGUE(); } \
        { const int n2 = n + 2; if (n2 < total) { const bool nx = (n2 >> 4) != (n >> 4); PEERS_LOAD(nx ? t + NWAVES : t, n2 & 15, nx ? En0 : E0, nx ? En1 : E1, LRB, LG, LD); } } \
        PEER4_COMPUTE(0, CRB, CG, CD); ++n; } while (0)
__device__ __forceinline__ void peer_q4(Frame& F, const bf16* H2, const bf16* X1, const int* SELI, const float* SELG, float* OUT, int tfirst, int tend, const LAS float* g2s, const LAS float* nfws) {
    const int lane = F.lane, isel = (lane >> 3) & 7;
    const float* SELD = (const float*)(F.ws + WS_SELD);
    const __amdgpu_buffer_rsrc_t rexp = __builtin_amdgcn_make_buffer_rsrc((void*)(F.ws + WS_EXP8), (short)0, 16384 * 1024, 0x00020000);
    if (tfirst >= tend) return;
    const int total = ((tend - tfirst + NWAVES - 1) / NWAVES) * (NSEL / 8);
    int t = tfirst, n = 0;
    int E0 = SELI[(size_t)tfirst * NSEL + lane], E1 = SELI[(size_t)tfirst * NSEL + 64 + lane], En0 = 0, En1 = 0;
    v4u hr0 = *(const v4u*)(H2 + (size_t)tfirst * D + 16 * lane), hr1 = *(const v4u*)(H2 + (size_t)tfirst * D + 16 * lane + 8), xr0, xr1;
    v4u rbA[8], rbB[8], rbC[8]; float gA, sdA, gB, sdB, gC, sdC;
    rf32x16 acc;
    const int mrow_ = lane & 31, cm_ = 4 * (mrow_ >> 3) + (mrow_ & 3); const int aq_ = 4 * ((mrow_ >> 2) & 1) + (cm_ >> 2); const unsigned ash = 8u * (unsigned)(cm_ & 3);
    const int abp_ = (lane >> 5) * 32;
    const bool am0 = aq_ == 0, am1 = aq_ == 1, am2 = aq_ == 2, am3 = aq_ == 3, am4 = aq_ == 4, am5 = aq_ == 5, am6 = aq_ == 6, am7 = aq_ == 7;
    float hscale = 0.f, hoff = 0.f; unsigned hA0 = 0u, hA1 = 0u, hB0 = 0u, hB1 = 0u;
    PEERS_LOAD(tfirst, 0, E0, E1, rbA, gA, sdA); PEERS_LOAD(tfirst, 1, E0, E1, rbB, gB, sdB);
#pragma unroll 1
    while (n < total) {
        PEERS_SLOT(rbA, gA, sdA, rbC, gC, sdC);
        if (n < total) PEERS_SLOT(rbB, gB, sdB, rbA, gA, sdA);
        if (n < total) PEERS_SLOT(rbC, gC, sdC, rbB, gB, sdB);
    }
    PEERS_EPILOGUE();
}

struct Args { const float* in[22]; float* out; unsigned char* ws; };
__global__ void __launch_bounds__(NWAVES * 64, 2) fwd_megakernel(Args args) {
    extern __shared__ __attribute__((aligned(16))) unsigned char lds[];
    Frame F;
    F.lds = (LAS unsigned char*)lds; F.MISC = (volatile LAS unsigned*)(F.lds + MISC_OFF);
    F.tid = threadIdx.x; F.lane = F.tid & 63; F.wave = __builtin_amdgcn_readfirstlane(F.tid >> 6);
    F.G = gridDim.x; { const int bx = blockIdx.x; F.vcu = (F.G % 8 == 0) ? (bx % 8) * (F.G / 8) + bx / 8 : bx; }
#pragma unroll
    for (int i = 0; i < 22; ++i) F.in[i] = args.in[i];
    F.out = args.out; F.ws = args.ws; F.ctl = (gu32*)(args.ws + WS_CTL);
    for (int u = F.tid; u < (LDS_BYTES - LDSCTL_OFF) / 4; u += NWAVES * 64) ((LAS unsigned*)(F.lds + LDSCTL_OFF))[u] = 0u;
    __syncthreads();
    XcdBarrier bar = xcd_barrier_post((unsigned*)(F.ctl + CW_BAR), F.MISC + 8);
    unsigned char* ws = args.ws;
    bf16* XN = (bf16*)(ws + WS_XN); bf16* Qb = (bf16*)(ws + WS_Q); bf16* Kb = (bf16*)(ws + WS_K); bf16* Vb = (bf16*)(ws + WS_V); bf16* Pb = (bf16*)(ws + WS_P);
    bf16* GAb = (bf16*)(ws + WS_GA); bf16* GPb = (bf16*)(ws + WS_GP); bf16* MG = XN;     bf16* Q2 = (bf16*)(ws + WS_Q2);
    bf16* X1 = GAb;
    bf16* POOLED = (bf16*)F.out + (size_t)M * D;
    {
    const float* mod = (const float*)(ws + WS_MODF);
    const int gw = F.vcu * NWAVES + F.wave, NGW = F.G * NWAVES;

    refresh(F); p0a_prologue(F);
    xcd_barrier(bar);
    refresh(F); p0b_rows(F, XN);
    xcd_barrier(bar);
    refresh(F); { pg8::Gemm g{XN, (const bf16*)(ws + WS_WIN), M, DIN, D, D, 0}; pg8::StaticOrder S; S.init(M, DIN, F.G, (int)blockIdx.x);
      pg8::EpiInProj E{Qb, (size_t)(WS_K - WS_Q) / 2, C2};
      pg8::gemm_phase<pg8::EpiInProj, pg8::StaticOrder, true, true>(F.lds, g, S, E); }
    xcd_barrier(bar);
    refresh(F); {
      { LAS float* tb = (LAS float*)(F.lds + attn_body::LDS_TAB);
        fill_bias_table2(F, tb, (F.vcu >> 1) & 7);
        float lam; { const float a = F.in[6][F.lane] * F.in[7][F.lane], bq = F.in[8][F.lane] * F.in[9][F.lane]; lam = __expf(wave_sum(a)) - __expf(wave_sum(bq)) + 0.2f; }
        const attn_body::AttnTensors AT{(const attn_body::bf16*)Qb, (const attn_body::bf16*)Kb, (const attn_body::bf16*)Vb, (const attn_body::bf16*)GAb, (attn_body::bf16*)MG};
        attn_body::attn_phase<8>((char*)lds, AT, F.vcu, (attn_body::lds_fptr)tb, lam, F.in[10]); }
      for (int it = gw; it < BATCH * 32 * 4; it += NGW) { const int g = it & 3, chunk = (it >> 2) & 31, b = it >> 7;
          if (g == 0) pool_item<2>(Pb, POOLED, b, chunk, 0, F.lane); else if (g == 1) pool_item<4>(Pb, POOLED, b, chunk, 1, F.lane);
          else if (g == 2) pool_item<8>(Pb, POOLED, b, chunk, 2, F.lane); else pool_item<16>(Pb, POOLED, b, chunk, 3, F.lane); } }
    xcd_barrier(bar);
    refresh(F); { pg8::Gemm g{POOLED, (const bf16*)(ws + WS_WPOOL), M, D, 256, D, 256}; pg8::StaticOrder S; S.init(M, D, F.G, (int)blockIdx.x);
      pg8::EpiPool E{MG, GPb, D};
      pg8::gemm_phase<pg8::EpiPool, pg8::StaticOrder, true, true>(F.lds, g, S, E); }
    xcd_barrier(bar);
    refresh(F); { pg8::Gemm g{MG, (const bf16*)(ws + WS_WOUT), M, D, D, D, 0}; pg8::StaticOrder S; S.init(M, D, F.G, (int)blockIdx.x);
      pg8::EpiResidBf E{F.in[0], X1, mod + 2048, D, DIN, SEQ};
      pg8::gemm_phase<pg8::EpiResidBf, pg8::StaticOrder, true, true>(F.lds, g, S, E); }
    xcd_barrier(bar);
    refresh(F); norm_mod_rows_t<true>(F, X1, F.in[15], 3072, 4096, XN, 1e-6f);
    xcd_barrier(bar);
    refresh(F); { pg8::Gemm g{XN, (const bf16*)(ws + WS_WQ), M, DQ2, D, D, 0}; pg8::StaticOrder S; S.init(M, DQ2, F.G, (int)blockIdx.x);
      pg8::EpiQFrag E{Q2};
      pg8::gemm_phase<pg8::EpiQFrag, pg8::StaticOrder, true, true>(F.lds, g, S, E); }
    xcd_barrier(bar);
    refresh(F);
    { const bf16* KEYSb = (const bf16*)(ws + WS_KEYS); int* SELIp = (int*)(ws + WS_SELI); float* SELGp = (float*)(ws + WS_SELG);
      LAS float* g2s = (LAS float*)F.lds; LAS float* nfws = g2s + D;
      for (int i = F.tid; i < D; i += NWAVES * 64) { g2s[i] = mod[((F.vcu * 128) >> 11) * DIN + 5120 + i]; nfws[i] = F.in[21][i]; }
#pragma unroll 1
      for (int g = -1; g < 4; ++g) {
#pragma unroll 1
          for (int s = 0; s < 2; ++s) {
              if ((s == 0) == (F.wave < 4)) { if (g < 3) retrieval_mfma(F, Q2, KEYSb, SELIp, SELGp, g + 1, g + 2); }
              else if (g >= 0) peer_q4(F, XN, X1, SELIp, SELGp, F.out, F.vcu * 128 + g * 32 + F.wave, F.vcu * 128 + g * 32 + 32, g2s, nfws);
          }
          VM_WAIT(); __syncthreads();
      } }
    }
}

extern "C" void kernel_launch(void* const* d_in, const int* in_sizes, int n_in, void* d_out, int out_size, void* d_ws, size_t ws_size, hipStream_t stream) {
    static int grid = 0;
    if (grid == 0) {
        if (n_in != 22 || in_sizes[0] != M * D || out_size != M * D || ws_size < WS_END) { fprintf(stderr, "kernel_launch: unexpected shapes/workspace (n_in %d, in0 %d, out %d, ws %zu < %zu); nothing launched\n", n_in, n_in > 0 ? in_sizes[0] : -1, out_size, ws_size, (size_t)WS_END); grid = -1; return; }
        int dev = 0, cus = 0;
        if (hipGetDevice(&dev) != hipSuccess || hipDeviceGetAttribute(&cus, hipDeviceAttributeMultiprocessorCount, dev) != hipSuccess) { grid = -1; return; }
        if (hipFuncSetAttribute((const void*)fwd_megakernel, hipFuncAttributeMaxDynamicSharedMemorySize, LDS_BYTES) != hipSuccess) { fprintf(stderr, "kernel_launch: hipFuncSetAttribute failed\n"); grid = -1; return; }
        int per_cu = 0;
        if (hipOccupancyMaxActiveBlocksPerMultiprocessor(&per_cu, (const void*)fwd_megakernel, NWAVES * 64, LDS_BYTES) != hipSuccess || per_cu < 1) fprintf(stderr, "kernel_launch: occupancy query reports %d\n", per_cu);
        (void)hipGetLastError();
        grid = cus;
    }
    if (grid < 0) return;
    if (hipMemsetAsync((char*)d_ws + WS_CTL, 0, CTL_ZERO_BYTES, stream) != hipSuccess) { fprintf(stderr, "kernel_launch: memset failed\n"); return; }
    Args a{};
    for (int i = 0; i < 22; ++i) a.in[i] = (const float*)d_in[i];
    a.out = (float*)d_out; a.ws = (unsigned char*)d_ws;
    hipLaunchKernelGGL(fwd_megakernel, dim3(grid), dim3(NWAVES * 64), LDS_BYTES, stream, a);
}
```

```cpp
#include <hip/hip_runtime.h>
#include <cstdio>
#include <cstdint>
namespace pg8 {
#define PG8_LAS __attribute__((address_space(3)))
typedef unsigned short bf16_t;
typedef short bf16x8 __attribute__((ext_vector_type(8)));
typedef float f32x4 __attribute__((ext_vector_type(4)));
typedef unsigned u32x4 __attribute__((ext_vector_type(4)));
constexpr int BM = 256, BK = 64, HALF = 128, HTB = HALF * BK * 2  , STAGE_BYTES = 8 * HTB, NXCD = 8, WGM = 8;

__host__ __device__ __forceinline__ int lds_byte(int r, int c) { const int st = (r >> 4) * 2 + (c >> 5), rr = r & 15, cc = c & 31, ob = rr * 64 + cc * 2; return st * 1024 + (ob ^ (((ob >> 9) & 1) << 5)); }
__host__ __device__ __forceinline__ void stage_rc(int b, int& R, int& C) { const int st = b / 1024, sb = b % 1024, swz = sb ^ (((sb >> 9) & 1) << 5); R = (st >> 1) * 16 + swz / 64; C = (st & 1) * 32 + (swz % 64) / 2; }
__host__ __device__ __forceinline__ int perm32(int rho) { const int n = rho >> 4, i = rho & 15; return 8 * (i >> 2) + 4 * n + (i & 3); }

struct Unit { int pm, pn; };
struct Gemm { const bf16_t* A; const bf16_t* Bt; int M, N, K, lda, a_pn; };

struct StaticOrder {
    int nM, nN, nwg, G, c;
    __host__ __device__ void init(int M, int N, int G_, int c_) { nM = M / BM; nN = N / BM; nwg = nM * nN; G = G_; c = c_; }
    __host__ __device__ bool next(int i, Unit& u) const {
        const long L = (long)i * G + c; if (L >= nwg) return false;
        int wgid = (int)L; { const int q = nwg / NXCD, r = nwg % NXCD, xcd = wgid % NXCD, off = wgid / NXCD; wgid = (xcd < r ? xcd * (q + 1) : r * (q + 1) + (xcd - r) * q) + off; }
        const int nig = WGM * nN, gid = wgid / nig, fm = gid * WGM, gsz = (nM - fm) < WGM ? (nM - fm) : WGM;
        u.pm = fm + ((wgid % nig) % gsz); u.pn = (wgid % nig) / gsz; return true;
    }
    __device__ __forceinline__ void a_ready(const Unit&) const {}
    __device__ __forceinline__ void done(const Unit&) const {}
};

__device__ __forceinline__ unsigned cvt_pk_bf16(float lo, float hi) { unsigned r; asm volatile("v_cvt_pk_bf16_f32 %0, %1, %2" : "=v"(r) : "v"(lo), "v"(hi)); return r; }
typedef float f32x2 __attribute__((ext_vector_type(2)));
__device__ __forceinline__ f32x2 gelu_pk(f32x2 v) {
    const f32x2 av = __builtin_elementwise_abs(v), d = av * 0.2316418882f + 1.0f;
    f32x2 t; t.x = __builtin_amdgcn_rcpf(d.x); t.y = __builtin_amdgcn_rcpf(d.y);
    f32x2 q = t * 0.5307027145f + (-0.7265760135f); q = q * t + 0.7107068705f; q = q * t + (-0.142248368f); q = q * t + 0.127414796f; q = q * t;
    const f32x2 s = (v * v) * (-0.72134752044f);
    f32x2 e; e.x = __builtin_amdgcn_exp2f(s.x); e.y = __builtin_amdgcn_exp2f(s.y);
    const f32x2 m = v * (q * e), r = v - m;
    f32x2 o; o.x = v.x < 0.f ? m.x : r.x; o.y = v.y < 0.f ? m.y : r.y; return o;
}

template <int ACT  > struct EpiBf16 {
    static constexpr bool PERM = true, AFTER_DRAIN = false; static_assert(ACT == 0 || ACT == 1, "EpiBf16: ACT is 0 (none) or 1 (gelu_pk)");
    bf16_t* O; int ldc; const float* bias; int split_cols; size_t split_stride; float scale0;
    __device__ __forceinline__ void operator()(const f32x4 (&acc)[2][2][4][2], const Unit& u, int wr, int wc, int fr, int fq) const {
        const int row0 = u.pm * BM + wr * 64 + fr; int colt = u.pn * BM; bf16_t* base = O;
        float sc = 1.f; if (split_cols) { const int t = colt / split_cols; base += (size_t)t * split_stride; colt -= t * split_cols; if (t == 0) sc = scale0; }
        const int col0 = colt + wc * 32 + 8 * fq, bcol0 = u.pn * BM + wc * 32 + 8 * fq;
        f32x4 bv[2][2];
#pragma unroll
        for (int bj = 0; bj < 2; ++bj)
#pragma unroll
            for (int n = 0; n < 2; ++n) bv[bj][n] = bias ? *(const f32x4*)(bias + bcol0 + bj * HALF + 4 * n) : (f32x4){0.f, 0.f, 0.f, 0.f};
#pragma unroll
        for (int ai = 0; ai < 2; ++ai)
#pragma unroll
            for (int m = 0; m < 4; ++m) { bf16_t* rowp = base + (size_t)(row0 + ai * HALF + m * 16) * ldc + col0;
#pragma unroll
                for (int bj = 0; bj < 2; ++bj) { f32x4 v0 = acc[ai][bj][m][0] + bv[bj][0], v1 = acc[ai][bj][m][1] + bv[bj][1];
                    if (ACT == 1) { f32x2 a = gelu_pk((f32x2){v0[0], v0[1]}), b = gelu_pk((f32x2){v0[2], v0[3]}), c = gelu_pk((f32x2){v1[0], v1[1]}), d = gelu_pk((f32x2){v1[2], v1[3]});
                        v0 = (f32x4){a.x, a.y, b.x, b.y}; v1 = (f32x4){c.x, c.y, d.x, d.y}; }
                    v0 = v0 * sc; v1 = v1 * sc; u32x4 w; w.x = cvt_pk_bf16(v0[0], v0[1]); w.y = cvt_pk_bf16(v0[2], v0[3]); w.z = cvt_pk_bf16(v1[0], v1[1]); w.w = cvt_pk_bf16(v1[2], v1[3]);
                    *(u32x4*)(rowp + bj * HALF) = w; } }
    }
};
__device__ __forceinline__ float bf_lo(unsigned w) { return __builtin_bit_cast(float, w << 16); }
__device__ __forceinline__ float bf_hi(unsigned w) { return __builtin_bit_cast(float, w & 0xffff0000u); }
__device__ __forceinline__ float sigmoidf_(float x) { return __builtin_amdgcn_rcpf(1.0f + __builtin_amdgcn_exp2f(-1.4426950408889634f * x)); }
struct EpiPool {
    static constexpr bool PERM = true, AFTER_DRAIN = false;
    bf16_t* MG; const bf16_t* GP; int ldc;
    __device__ __forceinline__ void operator()(const f32x4 (&acc)[2][2][4][2], const Unit& u, int wr, int wc, int fr, int fq) const {
        const int row0 = u.pm * BM + wr * 64 + fr, col0 = u.pn * BM + wc * 32 + 8 * fq;
#pragma unroll
        for (int ai = 0; ai < 2; ++ai)
#pragma unroll
            for (int m = 0; m < 4; ++m) { const size_t ro = (size_t)(row0 + ai * HALF + m * 16) * ldc + col0;
#pragma unroll
                for (int bj = 0; bj < 2; ++bj) {
                    const u32x4 mg = *(const u32x4*)(MG + ro + bj * HALF), gp = *(const u32x4*)(GP + ro + bj * HALF);
                    const f32x4 a0 = acc[ai][bj][m][0], a1 = acc[ai][bj][m][1];
                    u32x4 w;
                    w.x = cvt_pk_bf16(bf_lo(mg.x) + a0[0] * sigmoidf_(bf_lo(gp.x)), bf_hi(mg.x) + a0[1] * sigmoidf_(bf_hi(gp.x)));
                    w.y = cvt_pk_bf16(bf_lo(mg.y) + a0[2] * sigmoidf_(bf_lo(gp.y)), bf_hi(mg.y) + a0[3] * sigmoidf_(bf_hi(gp.y)));
                    w.z = cvt_pk_bf16(bf_lo(mg.z) + a1[0] * sigmoidf_(bf_lo(gp.z)), bf_hi(mg.z) + a1[1] * sigmoidf_(bf_hi(gp.z)));
                    w.w = cvt_pk_bf16(bf_lo(mg.w) + a1[2] * sigmoidf_(bf_lo(gp.w)), bf_hi(mg.w) + a1[3] * sigmoidf_(bf_hi(gp.w)));
                    *(u32x4*)(MG + ro + bj * HALF) = w; }
                asm volatile("" ::: "memory"); }
    }
};
struct EpiResidBf {
    static constexpr bool PERM = true, AFTER_DRAIN = false;
    const float* x; bf16_t* out; const float* gate; int ldc, gpitch, rows_per_b;
    __device__ __forceinline__ void operator()(const f32x4 (&acc)[2][2][4][2], const Unit& u, int wr, int wc, int fr, int fq) const {
        const int row0 = u.pm * BM + wr * 64 + fr, col0 = u.pn * BM + wc * 32 + 8 * fq;
        const float* gb = gate + (size_t)((u.pm * BM) / rows_per_b) * gpitch + col0;
        f32x4 gv[2][2];
#pragma unroll
        for (int bj = 0; bj < 2; ++bj)
#pragma unroll
            for (int n = 0; n < 2; ++n) gv[bj][n] = *(const f32x4*)(gb + bj * HALF + 4 * n);
#pragma unroll
        for (int ai = 0; ai < 2; ++ai)
#pragma unroll
            for (int m = 0; m < 4; ++m) { const size_t ro = (size_t)(row0 + ai * HALF + m * 16) * ldc + col0;
#pragma unroll
                for (int bj = 0; bj < 2; ++bj) { const f32x4 x0 = *(const f32x4*)(x + ro + bj * HALF), x1 = *(const f32x4*)(x + ro + bj * HALF + 4);
                    const f32x4 v0 = x0 + gv[bj][0] * acc[ai][bj][m][0], v1 = x1 + gv[bj][1] * acc[ai][bj][m][1];
                    u32x4 w; w.x = cvt_pk_bf16(v0[0], v0[1]); w.y = cvt_pk_bf16(v0[2], v0[3]); w.z = cvt_pk_bf16(v1[0], v1[1]); w.w = cvt_pk_bf16(v1[2], v1[3]);
                    *(u32x4*)(out + ro + bj * HALF) = w; } }
    }
};
struct EpiQFrag {
    static constexpr bool PERM = true, AFTER_DRAIN = false;
    bf16_t* O;
    __device__ __forceinline__ void operator()(const f32x4 (&acc)[2][2][4][2], const Unit& u, int wr, int wc, int fr, int fq) const {
        const int row0 = u.pm * BM + wr * 64 + fr;
#pragma unroll
        for (int ai = 0; ai < 2; ++ai)
#pragma unroll
            for (int m = 0; m < 4; ++m) { const int r = row0 + ai * HALF + m * 16;
#pragma unroll
                for (int bj = 0; bj < 2; ++bj) { const f32x4 v0 = acc[ai][bj][m][0], v1 = acc[ai][bj][m][1];
                    u32x4 w; w.x = cvt_pk_bf16(v0[0], v0[1]); w.y = cvt_pk_bf16(v0[2], v0[3]); w.z = cvt_pk_bf16(v1[0], v1[1]); w.w = cvt_pk_bf16(v1[2], v1[3]);
                    *(u32x4*)(O + ((size_t)(((r >> 5) * 8 + u.pn) * 2 + bj) * 4096 + (wc * 2 + (fq >> 1)) * 512 + ((fq & 1) * 32 + (r & 31)) * 8)) = w; } }
    }
};
struct EpiInProj {
    static constexpr bool PERM = true, AFTER_DRAIN = false;
    bf16_t* O; size_t stride; float scale0;
    __device__ __forceinline__ void operator()(const f32x4 (&acc)[2][2][4][2], const Unit& u, int wr, int wc, int fr, int fq) const {
        const int row0 = u.pm * BM + wr * 64 + fr; int colt = u.pn * BM; const int t = colt >> 10; colt &= 1023;
        bf16_t* base = O + (size_t)t * stride; const float sc = (t == 0) ? scale0 : 1.f;
        const int col0 = colt + wc * 32 + 8 * fq;
#pragma unroll
        for (int ai = 0; ai < 2; ++ai)
#pragma unroll
            for (int m = 0; m < 4; ++m) { const int r = row0 + ai * HALF + m * 16;
#pragma unroll
                for (int bj = 0; bj < 2; ++bj) { const int c = col0 + bj * HALF; const f32x4 v0 = acc[ai][bj][m][0] * sc, v1 = acc[ai][bj][m][1] * sc;
                    u32x4 w; w.x = cvt_pk_bf16(v0[0], v0[1]); w.y = cvt_pk_bf16(v0[2], v0[3]); w.z = cvt_pk_bf16(v1[0], v1[1]); w.w = cvt_pk_bf16(v1[2], v1[3]);
                    size_t off;
                    if (false) off = (size_t)(((((r >> 11) * 16 + (c >> 6)) * 32 + ((r >> 6) & 31)) * 8 + ((c >> 3) & 7)) * 512 + (r & 63) * 8);
                    else if (false) off = (size_t)((((((r >> 11) * 8 + (c >> 7)) * 32 + ((r >> 6) & 31)) * 4 + ((c >> 5) & 3)) * 64 + (r & 63)) * 32 + (c & 31));
                    else off = (size_t)r * 1024 + c;
                    *(u32x4*)(base + off) = w; } }
    }
};
template <class Epi, class Sched, bool ALIGN_EPI = false, bool SP2 = false>
__device__ __forceinline__ void gemm_phase(PG8_LAS unsigned char* lds, const Gemm g, const Sched& S, const Epi& E) {
    int tid = threadIdx.x; asm volatile("" : "+v"(tid));
    const int wid = __builtin_amdgcn_readfirstlane(tid >> 6), lane = tid & 63, wr = wid >> 2, wc = wid & 3, fr = lane & 15, fq = lane >> 4;
    int K = g.K; asm volatile("" : "+s"(K));
    const int nt = K / BK;
    unsigned voffA[2], voffB[2];
#pragma unroll
    for (int i = 0; i < 2; ++i) { int R, C; stage_rc(tid * 16 + i * 8192, R, C); const int Rb = Epi::PERM ? ((R & ~31) + perm32(R & 31)) : R;
        voffA[i] = (unsigned)(R * g.lda + C) * 2u; voffB[i] = (unsigned)(Rb * K + C) * 2u; }
    const size_t kstep = (size_t)(BK * 2);
    const size_t hstepA = (size_t)HALF * g.lda * 2, hstepB = (size_t)HALF * K * 2;
    const size_t tstepA = 2 * hstepA, tstepB = 2 * hstepB, pnA = (size_t)g.a_pn * 2;
    const unsigned ldsw = (unsigned)wid * 1024u;
    const int aoff = lds_byte(wr * 64 + fr, fq * 8), boff = lds_byte(wc * 32 + fr, fq * 8);
#define PG8_SA(b, h) (((b) * 2 + (h)) * HTB)
#define PG8_SB(b, h) ((4 + (b) * 2 + (h)) * HTB)
#define PG8_STAGE(bufoff, gbase, voff) do { _Pragma("unroll") for (int _i = 0; _i < 2; ++_i) \
        __builtin_amdgcn_global_load_lds((const unsigned*)((const char*)(gbase) + (voff)[_i]), (PG8_LAS unsigned*)(lds + (bufoff) + ldsw + _i * 8192), 16, 0, 0); } while (0)
#define PG8_LDA(dst, b, h) do { _Pragma("unroll") for (int m = 0; m < 4; ++m) _Pragma("unroll") for (int k = 0; k < 2; ++k) dst[m][k] = *(const PG8_LAS bf16x8*)(lds + PG8_SA(b, h) + aoff + m * 2048 + k * 1024); } while (0)
#define PG8_LDB(dst, b, h) do { _Pragma("unroll") for (int n = 0; n < 2; ++n) _Pragma("unroll") for (int k = 0; k < 2; ++k) dst[n][k] = *(const PG8_LAS bf16x8*)(lds + PG8_SB(b, h) + boff + n * 2048 + k * 1024); } while (0)
#define PG8_MMA(ai, bj, At, Bt) do { __builtin_amdgcn_s_setprio(1); _Pragma("unroll") for (int m = 0; m < 4; ++m) _Pragma("unroll") for (int n = 0; n < 2; ++n) _Pragma("unroll") for (int k = 0; k < 2; ++k) \
        acc[ai][bj][m][n] = __builtin_amdgcn_mfma_f32_16x16x32_bf16(Bt[n][k], At[m][k], acc[ai][bj][m][n], 0, 0, 0); __builtin_amdgcn_s_setprio(0); } while (0)
#define PG8_WAIT_V(n) asm volatile("s_waitcnt vmcnt(" #n ")" ::: "memory")
#define PG8_WAIT_L(n) asm volatile("s_waitcnt lgkmcnt(" #n ")" ::: "memory")
#define PG8_BAR __builtin_amdgcn_s_barrier()
#define PG8_SCHED __builtin_amdgcn_sched_barrier(0)
    Unit cur, nxt; int ui = 0;
    if (!S.next(0, cur)) return;
    f32x4 acc[2][2][4][2];
#pragma unroll
    for (int a = 0; a < 2; ++a)
#pragma unroll
        for (int b = 0; b < 2; ++b)
#pragma unroll
            for (int m = 0; m < 4; ++m)
#pragma unroll
                for (int n = 0; n < 2; ++n) acc[a][b][m][n] = (f32x4){0.f, 0.f, 0.f, 0.f};
    bf16x8 At[4][2], B0[2][2], B1[2][2];
    const char* cA = (const char*)g.A + (size_t)cur.pm * tstepA + (size_t)cur.pn * pnA; const char* cB = (const char*)g.Bt + (size_t)cur.pn * tstepB;
    S.a_ready(cur);
    if constexpr (SP2) {
        PG8_STAGE(PG8_SB(0, 0), cB, voffB); PG8_STAGE(PG8_SB(0, 1), cB + hstepB, voffB); PG8_STAGE(PG8_SA(0, 0), cA, voffA); PG8_STAGE(PG8_SA(0, 1), cA + hstepA, voffA);
        if (wr == 1) PG8_BAR;
        PG8_WAIT_V(2); PG8_BAR;
        PG8_STAGE(PG8_SB(1, 0), cB + kstep, voffB); PG8_STAGE(PG8_SA(1, 0), cA + kstep, voffA); PG8_STAGE(PG8_SB(1, 1), cB + hstepB + kstep, voffB);
        PG8_WAIT_V(6); PG8_BAR;
    } else {
        PG8_STAGE(PG8_SB(0, 0), cB, voffB); PG8_STAGE(PG8_SA(0, 0), cA, voffA); PG8_STAGE(PG8_SB(0, 1), cB + hstepB, voffB); PG8_STAGE(PG8_SA(0, 1), cA + hstepA, voffA);
        if (wr == 1) PG8_BAR;
        PG8_WAIT_V(4); PG8_BAR;
        PG8_STAGE(PG8_SB(1, 0), cB + kstep, voffB); PG8_STAGE(PG8_SA(1, 0), cA + kstep, voffA); PG8_STAGE(PG8_SB(1, 1), cB + hstepB + kstep, voffB);
        PG8_WAIT_V(6); PG8_BAR;
    }
    for (;;) {
        const bool has_next = S.next(ui + 1, nxt);
        const char* nA = has_next ? (const char*)g.A + (size_t)nxt.pm * tstepA + (size_t)nxt.pn * pnA : cA; const char* nB = has_next ? (const char*)g.Bt + (size_t)nxt.pn * tstepB : cB;
        for (int t = 0; t < nt; t += 2) {
            const bool last = (t == nt - 2);
            const char* a1 = cA + (size_t)(t + 1) * kstep;
            const char* a2 = last ? nA : cA + (size_t)(t + 2) * kstep; const char* b2 = last ? nB : cB + (size_t)(t + 2) * kstep;
            const char* a3 = a2 + kstep; const char* b3 = b2 + kstep;
            if (last && has_next) S.a_ready(nxt);
            if constexpr (SP2) {
            PG8_LDB(B0, 0, 0); PG8_LDB(B1, 0, 1); PG8_SCHED; PG8_LDA(At, 0, 0); PG8_STAGE(PG8_SA(1, 1), a1 + hstepA, voffA);
            PG8_WAIT_V(8); PG8_WAIT_L(0); PG8_BAR; PG8_MMA(0, 0, At, B0); PG8_MMA(0, 1, At, B1); PG8_BAR; PG8_SCHED;
            PG8_LDA(At, 0, 1); PG8_STAGE(PG8_SB(0, 0), b2, voffB); PG8_STAGE(PG8_SB(0, 1), b2 + hstepB, voffB); PG8_STAGE(PG8_SA(0, 0), a2, voffA);
            PG8_WAIT_V(8); PG8_WAIT_L(0); PG8_BAR; PG8_MMA(1, 0, At, B0); PG8_MMA(1, 1, At, B1); PG8_BAR; PG8_SCHED;
            PG8_LDB(B0, 1, 0); PG8_LDB(B1, 1, 1); PG8_SCHED; PG8_LDA(At, 1, 0); PG8_STAGE(PG8_SA(0, 1), a2 + hstepA, voffA);
            PG8_WAIT_V(8); PG8_WAIT_L(0); PG8_BAR; PG8_MMA(0, 0, At, B0); PG8_MMA(0, 1, At, B1); PG8_BAR; PG8_SCHED;
            PG8_LDA(At, 1, 1); PG8_STAGE(PG8_SB(1, 0), b3, voffB); PG8_STAGE(PG8_SB(1, 1), b3 + hstepB, voffB); PG8_STAGE(PG8_SA(1, 0), a3, voffA);
            PG8_WAIT_V(8); PG8_WAIT_L(0); PG8_BAR; PG8_MMA(1, 0, At, B0); PG8_MMA(1, 1, At, B1); PG8_BAR; PG8_SCHED;
            } else {
            PG8_LDB(B0, 0, 0); PG8_SCHED; PG8_LDA(At, 0, 0); PG8_STAGE(PG8_SA(1, 1), a1 + hstepA, voffA);
            PG8_WAIT_L(8); PG8_BAR; PG8_WAIT_L(0); PG8_MMA(0, 0, At, B0); PG8_BAR; PG8_SCHED;
            PG8_LDB(B1, 0, 1); PG8_STAGE(PG8_SB(0, 0), b2, voffB);
            PG8_BAR; PG8_WAIT_L(0); PG8_MMA(0, 1, At, B1); PG8_BAR;
            PG8_LDA(At, 0, 1); PG8_STAGE(PG8_SA(0, 0), a2, voffA);
            PG8_BAR; PG8_WAIT_L(0); PG8_MMA(1, 0, At, B0); PG8_BAR; PG8_SCHED;
            PG8_STAGE(PG8_SB(0, 1), b2 + hstepB, voffB);
            PG8_WAIT_V(6); PG8_BAR; PG8_MMA(1, 1, At, B1); PG8_BAR;
            PG8_LDB(B0, 1, 0); PG8_SCHED; PG8_LDA(At, 1, 0); PG8_STAGE(PG8_SA(0, 1), a2 + hstepA, voffA);
            PG8_WAIT_L(8); PG8_BAR; PG8_WAIT_L(0); PG8_MMA(0, 0, At, B0); PG8_BAR; PG8_SCHED;
            PG8_LDB(B1, 1, 1); PG8_STAGE(PG8_SB(1, 0), b3, voffB);
            PG8_BAR; PG8_WAIT_L(0); PG8_MMA(0, 1, At, B1); PG8_BAR;
            PG8_LDA(At, 1, 1); PG8_STAGE(PG8_SA(1, 0), a3, voffA);
            PG8_BAR; PG8_WAIT_L(0); PG8_MMA(1, 0, At, B0); PG8_BAR; PG8_SCHED;
            PG8_STAGE(PG8_SB(1, 1), b3 + hstepB, voffB);
            PG8_WAIT_V(6); PG8_BAR; PG8_MMA(1, 1, At, B1); PG8_BAR;
            }
        }
        if constexpr (ALIGN_EPI) { if (wr == 0) PG8_BAR; }
        if constexpr (!Epi::AFTER_DRAIN) { E(acc, cur, wr, wc, fr, fq); S.done(cur); }
        if (!has_next) break;
#pragma unroll
        for (int a = 0; a < 2; ++a)
#pragma unroll
            for (int b = 0; b < 2; ++b)
#pragma unroll
                for (int m = 0; m < 4; ++m)
#pragma unroll
                    for (int n = 0; n < 2; ++n) acc[a][b][m][n] = (f32x4){0.f, 0.f, 0.f, 0.f};
        cur = nxt; cA = nA; cB = nB; ++ui;
        if constexpr (ALIGN_EPI) { if (wr == 1) PG8_BAR; }
    }
    PG8_WAIT_V(0);
    if constexpr (!ALIGN_EPI) { if (wr == 0) PG8_BAR; }
    PG8_BAR;
    if constexpr (Epi::AFTER_DRAIN) { E.fused(acc, cur, wr, wc, fr, fq, lds, wid, lane); S.done(cur); }
#undef PG8_SA
#undef PG8_SB
#undef PG8_STAGE
#undef PG8_LDA
#undef PG8_LDB
#undef PG8_MMA
#undef PG8_WAIT_V
#undef PG8_WAIT_L
#undef PG8_BAR
#undef PG8_SCHED
}
}
#define GAS __attribute__((address_space(1)))
#define LAS __attribute__((address_space(3)))
typedef unsigned short bf16;
typedef unsigned v4u __attribute__((ext_vector_type(4)));
typedef float f32x4 __attribute__((ext_vector_type(4)));
typedef short bf16x8 __attribute__((ext_vector_type(8)));
typedef GAS unsigned gu32;
typedef GAS unsigned long long gu64;
#define RLX_AGENT __ATOMIC_RELAXED, __HIP_MEMORY_SCOPE_AGENT
#define LDS_WAIT() asm volatile("s_waitcnt lgkmcnt(0)" ::: "memory")
#define VM_WAIT() asm volatile("s_waitcnt vmcnt(0)" ::: "memory")
__device__ __forceinline__ unsigned long long rt() { return __builtin_amdgcn_s_memrealtime(); }
__device__ __forceinline__ unsigned f2bf(float f) { unsigned u = __builtin_bit_cast(unsigned, f); return (u + 0x7fffu + ((u >> 16) & 1u)) >> 16; }
__device__ __forceinline__ unsigned pk2(float lo, float hi) { return f2bf(lo) | (f2bf(hi) << 16); }

#define XB_TMO      128
#define XB_XCNT(j)  (256  + 64 * (j))
#define XB_XSUB(j)  (1280 + 64 * (j))
#define XB_XGEN(j)  (2304 + 64 * (j))
#define XB_TOP      3328
#define XB_TOPGEN   3392
#define XCD_BAR_WORDS 3456
#define XB_SPIN_CAP (1u << 18)

__device__ __forceinline__ unsigned xb_ld(unsigned* p)              { return __hip_atomic_load(p, __ATOMIC_RELAXED, __HIP_MEMORY_SCOPE_AGENT); }
__device__ __forceinline__ unsigned xb_add(unsigned* p, unsigned v) { return __hip_atomic_fetch_add(p, v, __ATOMIC_RELAXED, __HIP_MEMORY_SCOPE_AGENT); }
__device__ __forceinline__ unsigned xb_xcc_id() { return (unsigned)__builtin_amdgcn_s_getreg((3 << 11) | 20) & 0xFu; }
#define XB_SPIN(cond, bar) do { unsigned _sp = 0; while (cond) { __builtin_amdgcn_s_sleep(1); \
    if ((++_sp & 255u) == 0u) { if (xb_ld(&(bar)[XB_TMO])) break; if (_sp > XB_SPIN_CAP) { atomicAdd(&(bar)[XB_TMO], 1u); break; } } } } while (0)

struct XcdBarrier {
    unsigned* bar; unsigned x;
    volatile LAS unsigned* st;
};

__device__ __forceinline__ XcdBarrier xcd_barrier_post(unsigned* bar, volatile LAS unsigned* st) {
    XcdBarrier b; b.bar = bar; b.x = xb_xcc_id(); b.st = st;
    if (threadIdx.x == 0) (void)xb_add(&bar[XB_XCNT(b.x)], 1u);
    return b;
}
__device__ __forceinline__ void xcd_barrier_complete(unsigned* bar, unsigned x, unsigned& nloc, unsigned& nx) {
    const unsigned G = gridDim.x * gridDim.y * gridDim.z;
    unsigned sum, cnt, mine, sp = 0u;
    for (;;) {
        sum = 0u; cnt = 0u; mine = 0u;
#pragma unroll
        for (unsigned j = 0; j < 16; ++j) { const unsigned c = xb_ld(&bar[XB_XCNT(j)]); sum += c; cnt += (c > 0u) ? 1u : 0u; mine = (j == x) ? c : mine; }
        if (sum == G) break;
        __builtin_amdgcn_s_sleep(1);
        if ((++sp & 255u) == 0u) { if (xb_ld(&bar[XB_TMO])) break; if (sp > XB_SPIN_CAP) { atomicAdd(&bar[XB_TMO], 1u); break; } }
    }
    nloc = mine > 0u ? mine : 1u; nx = cnt > 0u ? cnt : 1u;
}

__device__ __forceinline__ void xcd_barrier(const XcdBarrier& b) {
    asm volatile("s_waitcnt vmcnt(0)" ::: "memory");
    __syncthreads();
    if (threadIdx.x == 0) {
        unsigned* bar = b.bar;
        __builtin_amdgcn_s_waitcnt(0);
        unsigned nloc = b.st[0], nx = b.st[1];
        if (nloc == 0u) { xcd_barrier_complete(bar, b.x, nloc, nx); b.st[0] = nloc; b.st[1] = nx; }
        const unsigned old = xb_add(&bar[XB_XSUB(b.x)], 1u);
        const unsigned gen = old / nloc;
        if (old + 1u == (gen + 1u) * nloc) {
            __builtin_amdgcn_fence(__ATOMIC_RELEASE, "");
            asm volatile("s_waitcnt vmcnt(0)" ::: "memory");
            const unsigned og = xb_add(&bar[XB_TOP], 1u);
            const unsigned tg = og / nx;
            if (og + 1u == (tg + 1u) * nx) xb_add(&bar[XB_TOPGEN], 1u);
            else XB_SPIN(xb_ld(&bar[XB_TOPGEN]) == tg, bar);
            __builtin_amdgcn_fence(__ATOMIC_ACQUIRE, "");
            xb_add(&bar[XB_XGEN(b.x)], 1u);
            asm volatile("s_waitcnt vmcnt(0)" ::: "memory");
        } else {
            XB_SPIN(xb_ld(&bar[XB_XGEN(b.x)]) == gen, bar);
            __builtin_amdgcn_fence(__ATOMIC_ACQUIRE, "");
            asm volatile("s_waitcnt vmcnt(0)" ::: "memory");
        }
    }
    __syncthreads();
}
#include <hip/hip_bf16.h>
#include <cmath>
namespace attn_body {
using bf16=__hip_bfloat16;
using bf16x8=__attribute__((ext_vector_type(8)))short;
using s16x4=__attribute__((ext_vector_type(4)))short;
using f32x16=__attribute__((ext_vector_type(16)))float;
using u32x4=__attribute__((ext_vector_type(4)))unsigned;
constexpr int BATCH=16,NVH=32,SEQ=2048,D=64,DM=1024;
constexpr int NW=8,QBLK=32,QB=QBLK*NW,KVBLK=64,NQB=SEQ/QB;
constexpr int ATTN_PITCH=DM, ATTN_UNIT_ROWS=QB;
__device__ __forceinline__ int crow(int r,int hi){return (r&3)+8*(r>>2)+4*hi;}
#define SBAR() __builtin_amdgcn_sched_barrier(0)
constexpr int BT_N=640;
typedef __attribute__((address_space(3))) const float* lds_fptr;
__device__ __forceinline__ void cmask(f32x16&p0,f32x16&p1,int jb,int qrel,int hi,lds_fptr tb){
  const lds_fptr base=tb+(qrel-64*jb-4*hi+256-59);
  asm volatile("s_waitcnt lgkmcnt(0)\n\ts_nop 7\n\ts_nop 7":"+v"(p0),"+v"(p1)::"memory"); SBAR();
  { float f[16];
    #pragma unroll
    for(int r=0;r<16;++r){const int c=(r&3)+8*(r>>2); f[r]=base[59-c];}
    asm volatile("s_waitcnt lgkmcnt(0)\n\ts_nop 7":"+v"(p0)::"memory"); SBAR();
    #pragma unroll
    for(int r=0;r<16;++r)p0[r]+=f[r];
    asm volatile("s_nop 3":"+v"(p0)::"memory"); SBAR(); }
  { float f[16];
    #pragma unroll
    for(int r=0;r<16;++r){const int c=(r&3)+8*(r>>2); f[r]=base[59-c-32];}
    asm volatile("s_waitcnt lgkmcnt(0)\n\ts_nop 7":"+v"(p1)::"memory"); SBAR();
    #pragma unroll
    for(int r=0;r<16;++r)p1[r]+=f[r];
    asm volatile("s_nop 3":"+v"(p1)::"memory"); SBAR(); }
}

constexpr int NSLOT=3, SLOTB=8192;
constexpr int LDS_K=0, LDS_V=2*NSLOT*SLOTB, LDS_WS=LDS_V+2*NSLOT*SLOTB, LDS_TAB=LDS_WS+NW*64*4, LDS_BYTES=LDS_TAB+640*4;
constexpr float C2=0.125f*1.4426950408889634f;
__device__ __forceinline__ void glds16(const void*gsrc,unsigned lds_dst){unsigned keep;
  asm volatile("s_mov_b32 %0, m0\n\ts_mov_b32 m0, %2\n\ts_nop 0\n\tglobal_load_lds_dwordx4 %1, off\n\ts_mov_b32 m0, %0":"=&s"(keep):"v"(gsrc),"s"(lds_dst):"memory");}
__device__ __forceinline__ float max3f(float a,float b,float c){float r;asm("v_max3_f32 %0, %1, %2, %3":"=v"(r):"v"(a),"v"(b),"v"(c));return r;}
__device__ __forceinline__ float max2f(float a,float b){float r;asm("v_max_f32_e32 %0, %1, %2":"=v"(r):"v"(a),"v"(b));return r;}
__device__ __forceinline__ float fadd_s(float a,float b){float r;asm("v_add_f32_e32 %0, %1, %2":"=v"(r):"v"(a),"v"(b));return r;}
__device__ __forceinline__ float fsub_s(float a,float b){float r;asm("v_sub_f32_e32 %0, %1, %2":"=v"(r):"v"(a),"v"(b));return r;}
typedef float f32x2_t __attribute__((ext_vector_type(2))); typedef __bf16 bf16x2_t __attribute__((ext_vector_type(2)));
__device__ __forceinline__ unsigned cvtpk_s(float lo,float hi){f32x2_t v={lo,hi};bf16x2_t b=__builtin_convertvector(v,bf16x2_t);return __builtin_bit_cast(unsigned,b);}
#define WAIT_BAR(N) asm volatile("s_waitcnt vmcnt(" #N ") lgkmcnt(0)\n\ts_barrier":::"memory")

__device__ __forceinline__ void qkt(f32x16&p0,f32x16&p1,const char*Kslot,const bf16x8*qr,const f32x16&negm,int r32,int hi){
  const char*kb=Kslot+hi*1024+r32*16;
  #pragma unroll
  for(int d0=0;d0<4;++d0){
    const bf16x8 b0=*reinterpret_cast<const bf16x8*>(kb+d0*2048);
    const bf16x8 b1=*reinterpret_cast<const bf16x8*>(kb+d0*2048+512);
    if(d0==0){p0=__builtin_amdgcn_mfma_f32_32x32x16_bf16(b0,qr[0],negm,0,0,0);p1=__builtin_amdgcn_mfma_f32_32x32x16_bf16(b1,qr[0],negm,0,0,0);}
    else{p0=__builtin_amdgcn_mfma_f32_32x32x16_bf16(b0,qr[d0],p0,0,0,0);p1=__builtin_amdgcn_mfma_f32_32x32x16_bf16(b1,qr[d0],p1,0,0,0);}}
}
typedef __attribute__((address_space(3))) const char* lds_cptr;
typedef short v4i16_t __attribute__((ext_vector_type(4)));
__device__ __forceinline__ void kload8(bf16x8*kf,lds_cptr kp){
  kf[0]=*(const __attribute__((address_space(3))) bf16x8*)(kp);      kf[1]=*(const __attribute__((address_space(3))) bf16x8*)(kp+512);
  kf[2]=*(const __attribute__((address_space(3))) bf16x8*)(kp+2048); kf[3]=*(const __attribute__((address_space(3))) bf16x8*)(kp+2560);
  kf[4]=*(const __attribute__((address_space(3))) bf16x8*)(kp+4096); kf[5]=*(const __attribute__((address_space(3))) bf16x8*)(kp+4608);
  kf[6]=*(const __attribute__((address_space(3))) bf16x8*)(kp+6144); kf[7]=*(const __attribute__((address_space(3))) bf16x8*)(kp+6656);
}
__device__ __forceinline__ void kload2(bf16x8*kf,lds_cptr kp,int j){ kf[2*j]=*(const __attribute__((address_space(3))) bf16x8*)(kp+j*2048); kf[2*j+1]=*(const __attribute__((address_space(3))) bf16x8*)(kp+j*2048+512); }
__device__ __forceinline__ s16x4 vtr(lds_cptr p){ return __builtin_bit_cast(s16x4,__builtin_amdgcn_ds_read_tr16_b64_v4i16((__attribute__((address_space(3))) v4i16_t*)p)); }
__device__ __forceinline__ float rowmax(const f32x16&p0,const f32x16&p1){
  float a=max3f(p0[0],p0[1],p1[0]),b=max3f(p0[2],p0[3],p1[1]);a=max3f(a,p1[2],p1[3]);
  #pragma unroll
  for(int r=4;r<16;r+=4){a=max3f(a,p0[r],p0[r+1]);b=max3f(b,p0[r+2],p0[r+3]);a=max3f(a,p1[r],p1[r+1]);b=max3f(b,p1[r+2],p1[r+3]);}
  const float m=max2f(a,b);
  auto rr=__builtin_amdgcn_permlane32_swap(__float_as_uint(m),__float_as_uint(m),false,false);
  return max2f(__uint_as_float(rr[0]),__uint_as_float(rr[1]));
}
#ifndef ATTN_STORE16
#define ATTN_STORE16(p,v) (*(u32x4*)(p)=(v))
#endif
template<int THRL> __device__ __forceinline__ void attn_unit(int b,int h,int qb,const bf16*Q,const bf16*__restrict__ K,const bf16*__restrict__ V,const bf16*__restrict__ GA,bf16*MGo,char*shm,lds_fptr tb,float lam,const float*subw){
  int tid=threadIdx.x; asm volatile("":"+v"(tid)); const int lane=tid&63,r32=lane&31,hi=lane>>5; const int wid=__builtin_amdgcn_readfirstlane(tid>>6), grp=wid>>2, w4=wid&3;
  const long rowbase=(long)b*SEQ; const int q0=qb*128, qcol=h*128+grp*64, vcol=h*128;
  const bf16*Qw=Q+(rowbase+q0+w4*QBLK)*DM+qcol;
  const bf16*Kh=K+rowbase*DM+qcol,*Vh=V+rowbase*DM+vcol;
  const unsigned lds0=(unsigned)(uintptr_t)shm;
  float*wsf=(float*)(shm+LDS_WS)+wid*64;
  const bf16*ksrc=Kh+(long)lane*DM+w4*16;
  const bf16*vsrc=Vh+(long)(16*(wid&3)+(lane>>2))*DM+(wid>>2)*32+(lane&3)*8;
  const unsigned kdst=lds0+LDS_K+grp*(NSLOT*SLOTB)+w4*2048, vdst=lds0+LDS_V+wid*1024;
  #define DMA_K1(t,ks) do{ glds16(ksrc+(long)(t)*KVBLK*DM,(unsigned)__builtin_amdgcn_readfirstlane(kdst+(ks))); glds16(ksrc+(long)(t)*KVBLK*DM+8,(unsigned)__builtin_amdgcn_readfirstlane(kdst+(ks)+1024)); }while(0)
  #define DMA_V2(t,vs) do{ glds16(vsrc+(long)(t)*KVBLK*DM,(unsigned)__builtin_amdgcn_readfirstlane(vdst+(vs))); glds16(vsrc+(long)(t)*KVBLK*DM+64,(unsigned)__builtin_amdgcn_readfirstlane(vdst+(vs)+8192)); }while(0)
  const lds_cptr shm3=(lds_cptr)shm; const lds_cptr vp0=shm3+LDS_V+((lane>>4)&1)*32+(lane&3)*8+(4*hi+((lane&15)>>2))*64;
  const lds_cptr kp0=shm3+LDS_K+grp*(NSLOT*SLOTB)+hi*1024+r32*16;
  const int NT=(q0+128)/KVBLK;
  asm volatile("s_waitcnt vmcnt(0)":::"memory");
  DMA_K1(0,0); DMA_K1(1,SLOTB); DMA_V2(0,0); if(NT>2)DMA_K1(2,2*SLOTB); DMA_V2(1,2*SLOTB);
  bf16x8 qr[4];
  #pragma unroll
  for(int d0=0;d0<4;++d0)qr[d0]=*reinterpret_cast<const bf16x8*>(&Qw[(long)r32*DM+d0*16+hi*8]);
  asm volatile("s_waitcnt vmcnt(0) lgkmcnt(0)\n\ts_barrier":::"memory");
  float mhat=0.f,l_reg=0.f; f32x16 o[4]; o[0]=f32x16{};o[1]=f32x16{};o[2]=f32x16{};o[3]=f32x16{}; f32x16 negm=f32x16{};
  const int qrel=w4*QBLK+r32;
  bool resc=false;
  #define MX3(a,b,c) __builtin_fmaxf(__builtin_fmaxf((a),(b)),(c))
  #define EX(v) __builtin_amdgcn_exp2f(v)
  #define KFR(off) (*(const __attribute__((address_space(3))) bf16x8*)(kp_+(off)))
  #define QKT(P0,P1) do{ P0=__builtin_amdgcn_mfma_f32_32x32x16_bf16(KFR(0),qr[0],negm,0,0,0); P1=__builtin_amdgcn_mfma_f32_32x32x16_bf16(KFR(512),qr[0],negm,0,0,0); \
      P0=__builtin_amdgcn_mfma_f32_32x32x16_bf16(KFR(2048),qr[1],P0,0,0,0); P1=__builtin_amdgcn_mfma_f32_32x32x16_bf16(KFR(2560),qr[1],P1,0,0,0); \
      P0=__builtin_amdgcn_mfma_f32_32x32x16_bf16(KFR(4096),qr[2],P0,0,0,0); P1=__builtin_amdgcn_mfma_f32_32x32x16_bf16(KFR(4608),qr[2],P1,0,0,0); \
      P0=__builtin_amdgcn_mfma_f32_32x32x16_bf16(KFR(6144),qr[3],P0,0,0,0); P1=__builtin_amdgcn_mfma_f32_32x32x16_bf16(KFR(6656),qr[3],P1,0,0,0); }while(0)
  #define DECIDE(P0,P1,RM) do{ resc=false; if(__builtin_expect(__any((RM)>(float)THRL),0)){ const float dl=__builtin_fmaxf((RM),0.f); mhat+=dl; \
        _Pragma("unroll") for(int r=0;r<16;++r){P0[r]-=dl;P1[r]-=dl;} \
        _Pragma("unroll") for(int r=0;r<16;++r)negm[r]=-mhat; \
        const float f=__builtin_amdgcn_exp2f(-dl); l_reg*=f; if(hi==0)wsf[r32]=f; resc=true; } }while(0)
  #define RESC() do{ if(resc){ asm volatile("s_waitcnt lgkmcnt(0)":::"memory"); \
      _Pragma("unroll") for(int d_=0;d_<4;++d_) _Pragma("unroll") for(int r=0;r<16;++r)o[d_][r]*=wsf[crow(r,hi)]; asm volatile("s_waitcnt lgkmcnt(0)":::"memory"); } }while(0)
  #define ROWMAX(P0,P1,RM) do{ float a_=MX3(P0[0],P0[1],P1[0]),b_=MX3(P0[2],P0[3],P1[1]); a_=MX3(a_,P1[2],P1[3]); \
      _Pragma("unroll") for(int r=4;r<16;r+=4){a_=MX3(a_,P0[r],P0[r+1]);b_=MX3(b_,P0[r+2],P0[r+3]);a_=MX3(a_,P1[r],P1[r+1]);b_=MX3(b_,P1[r+2],P1[r+3]);} \
      RM=__builtin_fmaxf(a_,b_); { auto rr=__builtin_amdgcn_permlane32_swap(__float_as_uint(RM),__float_as_uint(RM),false,false); RM=__builtin_fmaxf(__uint_as_float(rr[0]),__uint_as_float(rr[1])); } }while(0)
  #define PACK(P0,P1) do{ pw0=(u32x4){cvtpk_s(P0[0],P0[1]),cvtpk_s(P0[2],P0[3]),cvtpk_s(P0[4],P0[5]),cvtpk_s(P0[6],P0[7])}; pw1=(u32x4){cvtpk_s(P0[8],P0[9]),cvtpk_s(P0[10],P0[11]),cvtpk_s(P0[12],P0[13]),cvtpk_s(P0[14],P0[15])}; \
      pw2=(u32x4){cvtpk_s(P1[0],P1[1]),cvtpk_s(P1[2],P1[3]),cvtpk_s(P1[4],P1[5]),cvtpk_s(P1[6],P1[7])}; pw3=(u32x4){cvtpk_s(P1[8],P1[9]),cvtpk_s(P1[10],P1[11]),cvtpk_s(P1[12],P1[13]),cvtpk_s(P1[14],P1[15])}; }while(0)
  u32x4 pw[4];
  #define pw0 pw[0]
  #define pw1 pw[1]
  #define pw2 pw[2]
  #define pw3 pw[3]
  { const lds_cptr kp_=kp0; f32x16 p0,p1; QKT(p0,p1);
    { const int jb=0-(NT-2); if(jb>=-2)cmask(p0,p1,jb,qrel,hi,tb); }
    float rm; ROWMAX(p0,p1,rm); DECIDE(p0,p1,rm); RESC();
    float sacc=0.f;
    #pragma unroll
    for(int r=0;r<16;++r){p0[r]=EX(p0[r]);p1[r]=EX(p1[r]);sacc+=p0[r]+p1[r];}
    l_reg+=sacc; PACK(p0,p1); }
  int kn=SLOTB,vs=0;
  #define VFRAG(q_,s_) ({ const s16x4 lo_=vtr(vp_+(q_)*4096+(s_)*1024), hi_=vtr(vp_+(q_)*4096+(s_)*1024+512); (bf16x8){lo_[0],lo_[1],lo_[2],lo_[3],hi_[0],hi_[1],hi_[2],hi_[3]}; })
  #define PIN(x) asm volatile("":"+v"(x))
  #define PAW(k) __builtin_bit_cast(bf16x8,pw[k])
  #define FQA(i) ((i)<8?((i)&1):2+((i)&1))
  #define FSA(i) (((i)&7)>>1)
  #define FQB(i) ((i)&3)
  #define FSB(i) ((i)>>2)
  #define GAP3(i,FQ,FS,FILL) do{ if((i)+2<16) vf[((i)+2)%3]=VFRAG(FQ((i)+2),FS((i)+2)); o[FQ(i)]=__builtin_amdgcn_mfma_f32_32x32x16_bf16(PAW(FS(i)),vf[(i)%3],o[FQ(i)],0,0,0); FILL; SBAR(); }while(0)
  for(int t=0;t<NT;++t){
    if(t==0) asm volatile("s_waitcnt lgkmcnt(0)\n\ts_barrier":::"memory");
    else{ if(t+2<NT) asm volatile("s_waitcnt vmcnt(4) lgkmcnt(0)\n\ts_barrier":::"memory"); else if(t+1<NT) asm volatile("s_waitcnt vmcnt(2) lgkmcnt(0)\n\ts_barrier":::"memory"); else asm volatile("s_waitcnt vmcnt(0) lgkmcnt(0)\n\ts_barrier":::"memory"); }
    if(t+3<NT) DMA_K1(t+3,((t+3)%3)*SLOTB);
    if(t+2<NT) DMA_V2(t+2,((t+2)%3)*2*SLOTB);
    const lds_cptr vp_=vp0+vs;
    bf16x8 vf[3];
    if(t+1<NT){
      const lds_cptr kp_=kp0+kn; f32x16 p0,p1;
      bf16x8 kf[8]; SBAR();
      kf[0]=KFR(0);kf[1]=KFR(512);kf[2]=KFR(2048);kf[3]=KFR(2560);kf[4]=KFR(4096);kf[5]=KFR(4608);kf[6]=KFR(6144);kf[7]=KFR(6656); vf[0]=VFRAG(FQA(0),FSA(0)); vf[1]=VFRAG(FQA(1),FSA(1)); SBAR();
      p0=__builtin_amdgcn_mfma_f32_32x32x16_bf16(kf[0],qr[0],negm,0,0,0); p1=__builtin_amdgcn_mfma_f32_32x32x16_bf16(kf[1],qr[0],negm,0,0,0);
      p0=__builtin_amdgcn_mfma_f32_32x32x16_bf16(kf[2],qr[1],p0,0,0,0);   p1=__builtin_amdgcn_mfma_f32_32x32x16_bf16(kf[3],qr[1],p1,0,0,0);
      p0=__builtin_amdgcn_mfma_f32_32x32x16_bf16(kf[4],qr[2],p0,0,0,0);   p1=__builtin_amdgcn_mfma_f32_32x32x16_bf16(kf[5],qr[2],p1,0,0,0);
      p0=__builtin_amdgcn_mfma_f32_32x32x16_bf16(kf[6],qr[3],p0,0,0,0);   p1=__builtin_amdgcn_mfma_f32_32x32x16_bf16(kf[7],qr[3],p1,0,0,0); SBAR();
      GAP3(0,FQA,FSA,);  GAP3(1,FQA,FSA,);  GAP3(2,FQA,FSA,);  GAP3(3,FQA,FSA,);
      { const int jb=t+1-(NT-2); if(jb>=-2)cmask(p0,p1,jb,qrel,hi,tb); }
      float ma,mb,rm;
      GAP3(4,FQA,FSA, ma=MX3(p0[0],p0[1],p1[0]); mb=MX3(p0[2],p0[3],p1[1]); ma=MX3(ma,p1[2],p1[3]); PIN(ma); PIN(mb));
      GAP3(5,FQA,FSA, ma=MX3(ma,p0[4],p0[5]); mb=MX3(mb,p0[6],p0[7]); ma=MX3(ma,p1[4],p1[5]); mb=MX3(mb,p1[6],p1[7]); PIN(ma); PIN(mb));
      GAP3(6,FQA,FSA, ma=MX3(ma,p0[8],p0[9]); mb=MX3(mb,p0[10],p0[11]); ma=MX3(ma,p1[8],p1[9]); mb=MX3(mb,p1[10],p1[11]); PIN(ma); PIN(mb));
      GAP3(7,FQA,FSA, ma=MX3(ma,p0[12],p0[13]); mb=MX3(mb,p0[14],p0[15]); ma=MX3(ma,p1[12],p1[13]); mb=MX3(mb,p1[14],p1[15]); rm=__builtin_fmaxf(ma,mb); PIN(rm));
      { auto rr=__builtin_amdgcn_permlane32_swap(__float_as_uint(rm),__float_as_uint(rm),false,false); rm=__builtin_fmaxf(__uint_as_float(rr[0]),__uint_as_float(rr[1])); }
      DECIDE(p0,p1,rm);
      float sacc=0.f; u32x4 pn0,pn1,pn2,pn3; SBAR();
      #define FILLX(X,B,PN,I) X[B]=EX(X[B]); X[B+1]=EX(X[B+1]); X[B+2]=EX(X[B+2]); X[B+3]=EX(X[B+3]); sacc+=(X[B]+X[B+1])+(X[B+2]+X[B+3]); PN[I]=cvtpk_s(X[B],X[B+1]); PN[I+1]=cvtpk_s(X[B+2],X[B+3]); PIN(PN); PIN(sacc)
      GAP3(8,FQA,FSA, FILLX(p0,0,pn0,0));  GAP3(9,FQA,FSA, FILLX(p0,4,pn0,2));  GAP3(10,FQA,FSA, FILLX(p0,8,pn1,0));  GAP3(11,FQA,FSA, FILLX(p0,12,pn1,2));
      GAP3(12,FQA,FSA, FILLX(p1,0,pn2,0));  GAP3(13,FQA,FSA, FILLX(p1,4,pn2,2));  GAP3(14,FQA,FSA, FILLX(p1,8,pn3,0));  GAP3(15,FQA,FSA, FILLX(p1,12,pn3,2));
      #undef FILLX
      l_reg+=sacc; RESC(); pw0=pn0; pw1=pn1; pw2=pn2; pw3=pn3;
    } else {
      vf[0]=VFRAG(FQB(0),FSB(0)); vf[1]=VFRAG(FQB(1),FSB(1)); SBAR();
      GAP3(0,FQB,FSB,);  GAP3(1,FQB,FSB,);  GAP3(2,FQB,FSB,);  GAP3(3,FQB,FSB,);  GAP3(4,FQB,FSB,);  GAP3(5,FQB,FSB,);  GAP3(6,FQB,FSB,);  GAP3(7,FQB,FSB,);
      GAP3(8,FQB,FSB,);  GAP3(9,FQB,FSB,);  GAP3(10,FQB,FSB,);  GAP3(11,FQB,FSB,);  GAP3(12,FQB,FSB,);  GAP3(13,FQB,FSB,);  GAP3(14,FQB,FSB,);  GAP3(15,FQB,FSB,);
    }
    kn=(kn==2*SLOTB)?0:kn+SLOTB; vs=(vs==4*SLOTB)?0:vs+2*SLOTB;
  }
  #undef GAP3
  #undef FQA
  #undef FSA
  #undef FQB
  #undef FSB
  #undef pw0
  #undef pw1
  #undef pw2
  #undef pw3
  #undef PIN
  #undef PAW
  #undef VFRAG
  #undef PVM
  {auto rr=__builtin_amdgcn_permlane32_swap(__float_as_uint(l_reg),__float_as_uint(l_reg),false,false);l_reg=__uint_as_float(rr[0])+__uint_as_float(rr[1]);}
  if(hi==0)wsf[32+r32]=l_reg;asm volatile("s_waitcnt lgkmcnt(0)":::"memory");
  float rli[16];
  #pragma unroll
  for(int r=0;r<16;++r)rli[r]=__builtin_amdgcn_rcpf(wsf[32+crow(r,hi)]);
  asm volatile("s_waitcnt lgkmcnt(0)\n\ts_barrier":::"memory");
  { bf16*stg=(bf16*)shm+wid*4096;
    #pragma unroll
    for(int r=0;r<16;++r){const int orow=crow(r,hi);
      #pragma unroll
      for(int d0=0;d0<4;++d0)stg[orow*128+d0*32+r32]=__float2bfloat16(o[d0][r]*rli[r]);} }
  asm volatile("s_waitcnt lgkmcnt(0)\n\ts_barrier":::"memory");
  { const int row=16*grp+(lane>>2), c32=(lane&3)*32;
    const bf16*sa=(const bf16*)shm+w4*4096+row*128+c32, *sb=(const bf16*)shm+(4+w4)*4096+row*128+c32;
    const size_t go=(size_t)(rowbase+q0+w4*QBLK+row)*DM+vcol+c32;
    float d[32]; float ss=0.f;
    #pragma unroll
    for(int i=0;i<4;++i){ const u32x4 a1=*(const u32x4*)(sa+8*i), a2=*(const u32x4*)(sb+8*i);
      #pragma unroll
      for(int j=0;j<4;++j){ const unsigned x1=a1[j], x2=a2[j]; const float dl=__uint_as_float(x1<<16)-lam*__uint_as_float(x2<<16), dh=__uint_as_float(x1&0xffff0000u)-lam*__uint_as_float(x2&0xffff0000u);
        d[8*i+2*j]=dl; d[8*i+2*j+1]=dh; ss+=dl*dl+dh*dh; } }
    ss+=__shfl_xor(ss,1); ss+=__shfl_xor(ss,2);
    const float rr_=__builtin_amdgcn_rsqf(ss*(1.0f/128.0f)+1e-5f)*0.8f;
    #pragma unroll
    for(int i=0;i<4;++i){ const u32x4 ga=*(const u32x4*)(GA+go+8*i); const f32x4 s0=*(const f32x4*)(subw+c32+8*i), s1=*(const f32x4*)(subw+c32+8*i+4); u32x4 w;
      #pragma unroll
      for(int j=0;j<4;++j){ const unsigned g=ga[j]; const float gl=__uint_as_float(g<<16), gh=__uint_as_float(g&0xffff0000u);
        const float sl=(j<2)?s0[2*j]:s1[2*j-4], sh=(j<2)?s0[2*j+1]:s1[2*j-3];
        const float ol=__builtin_amdgcn_rcpf(1.0f+__builtin_amdgcn_exp2f(-1.4426950408889634f*gl))*d[8*i+2*j]*rr_*sl, oh=__builtin_amdgcn_rcpf(1.0f+__builtin_amdgcn_exp2f(-1.4426950408889634f*gh))*d[8*i+2*j+1]*rr_*sh;
        w[j]=cvtpk_s(ol,oh); }
      ATTN_STORE16(MGo+go+8*i,w); } }
  asm volatile("s_waitcnt lgkmcnt(0)\n\ts_barrier":::"memory");
  #undef DMA_K1
  #undef DMA_V2
  #undef MX3
  #undef EX
  #undef KFR
  #undef QKT
  #undef DECIDE
  #undef RESC
  #undef ROWMAX
  #undef PACK
}
constexpr int ATTN_LDS_BYTES=LDS_BYTES;
struct AttnTensors { const bf16* Q; const bf16* K; const bf16* V; const bf16* GA; bf16* MG; };
template<int THRL=8> __device__ __forceinline__ void attn_phase(char*lds,const AttnTensors&T,int vcu,lds_fptr tball,float lam,const float*subw){
  const int b=vcu>>4, h=(vcu>>1)&7, half=vcu&1;
  for(int i=0;i<8;++i){ const int pr=i>>1, qb=4*pr+(half?((i&1)?2:1):((i&1)?3:0));
    attn_unit<THRL>(b,h,qb,T.Q,T.K,T.V,T.GA,T.MG,lds,tball,lam,subw); }
}
#undef SBAR
#undef WAIT_BAR
}

constexpr int NWAVES = 8;
constexpr int BATCH = 16, SEQ = 2048, D = 1024, M = BATCH * SEQ, DIN = 6144, DQ2 = 2048, NSEL = 128;
constexpr float C2 = 0.125f * 1.4426950408889634f;
constexpr float LOG2E = 1.4426950408889634f;
constexpr size_t MiB = 1u << 20;
constexpr size_t WS_CTL = 0, CTL_ZERO_BYTES = 1 * MiB;
constexpr size_t WS_MOD = 128 * 1024;
constexpr size_t WS_WIN = 1 * MiB, WS_WOUT = 13 * MiB, WS_WQ = 15 * MiB, WS_WPOOL = 19 * MiB, WS_KEYS = 19 * MiB + 512 * 1024;
constexpr size_t WS_EXP8 = 20 * MiB;
constexpr size_t WS_SCALES = 36 * MiB;
constexpr size_t WS_MODF = 36 * MiB + 256 * 1024;
constexpr size_t WS_XN = 52 * MiB;
constexpr size_t WS_Q = 116 * MiB, WS_K = 180 * MiB, WS_V = 244 * MiB, WS_P = 308 * MiB, WS_GA = 372 * MiB, WS_GP = 436 * MiB, WS_END = 500 * MiB;
constexpr size_t WS_MG = WS_Q;
constexpr size_t WS_SELI = WS_P, WS_SELG = WS_P + 16 * MiB, WS_SELD = WS_P + 32 * MiB;
constexpr size_t WS_Q2 = WS_K;
constexpr int CW_BAR = 4096;
constexpr int RING_BYTES = 131072, LDSCTL_OFF = 153600, MISC_OFF = LDSCTL_OFF + 320, LDS_BYTES = 155648;

struct Frame {
    LAS unsigned char* lds; volatile LAS unsigned* MISC; gu32* ctl;
    int tid, lane, wave, vcu, G;
    const float* in[22]; float* out; unsigned char* ws;
};
__device__ __forceinline__ void refresh(Frame& F) { int t = threadIdx.x; asm volatile("" : "+v"(t)); F.tid = t; F.lane = t & 63; }
typedef int i32x4 __attribute__((ext_vector_type(4)));
__device__ __forceinline__ f32x4 ldmod4(const int* p) { const i32x4 v = *(const i32x4*)p; return (f32x4){(float)v.x, (float)v.y, (float)v.z, (float)v.w} * (1.0f / 16777216.0f); }
__device__ __forceinline__ float wave_sum(float v) {
#pragma unroll
    for (int o = 1; o < 64; o <<= 1) v += __shfl_xor(v, o);
    return v;
}
__device__ __forceinline__ float bflo(unsigned w) { return __builtin_bit_cast(float, w << 16); }
__device__ __forceinline__ float bfhi(unsigned w) { return __builtin_bit_cast(float, w & 0xffff0000u); }
__device__ __forceinline__ float sigm(float x) { return 1.0f / (1.0f + __expf(-x)); }

__device__ __forceinline__ void p0_transpose_item(const float* W, int K, int N, bf16* WT, int row_off, LAS float* scr, int item, int lane, const float* colscale = nullptr) {
    const int nblk = N / 32, kb = item / nblk, nb = item % nblk, k0 = 64 * kb, n0 = 32 * nb;
    const float cs = colscale ? colscale[n0 + (lane & 31)] : 1.0f;
#pragma unroll 8
    for (int i = 0; i < 32; ++i) { const int kk = 2 * i + (lane >> 5); scr[kk * 33 + (lane & 31)] = W[(size_t)(k0 + kk) * N + n0 + (lane & 31)] * cs; }
    LDS_WAIT(); asm volatile("" ::: "memory");
    const int c = lane & 7;
#pragma unroll
    for (int j = 0; j < 4; ++j) { const int n = (lane >> 3) + 8 * j; const LAS float* s = scr + (8 * c) * 33 + n;
        v4u o; o.x = pk2(s[0 * 33], s[1 * 33]); o.y = pk2(s[2 * 33], s[3 * 33]); o.z = pk2(s[4 * 33], s[5 * 33]); o.w = pk2(s[6 * 33], s[7 * 33]);
        *(GAS v4u*)(WT + (size_t)(row_off + n0 + n) * K + k0 + 8 * c) = o; }
    LDS_WAIT(); asm volatile("" ::: "memory");
}
__device__ __forceinline__ void p0_mod_item(Frame& F, int id, LAS float* scr) {
    const int cb = id % 96, kc = id / 96, n = cb * 64 + F.lane;
    const float* c = F.in[1]; const float* wada = F.in[2]; const float* bada = F.in[3];
#pragma unroll 4
    for (int i = 0; i < 32; ++i) { const int e = i * 64 + F.lane, b = e >> 7, k = e & 127; const float cv = c[b * D + kc * 128 + k]; scr[k * 16 + b] = cv / (1.0f + __expf(-cv)); }
    LDS_WAIT(); asm volatile("" ::: "memory");
    float acc[16];
#pragma unroll
    for (int b = 0; b < 16; ++b) acc[b] = 0.f;
#pragma unroll 4
    for (int k = 0; k < 128; ++k) {
        const float w = wada[(size_t)(kc * 128 + k) * DIN + n];
        const f32x4 c0 = *(const LAS f32x4*)(scr + k * 16), c1 = *(const LAS f32x4*)(scr + k * 16 + 4), c2 = *(const LAS f32x4*)(scr + k * 16 + 8), c3 = *(const LAS f32x4*)(scr + k * 16 + 12);
        acc[0] += c0.x * w; acc[1] += c0.y * w; acc[2] += c0.z * w; acc[3] += c0.w * w; acc[4] += c1.x * w; acc[5] += c1.y * w; acc[6] += c1.z * w; acc[7] += c1.w * w;
        acc[8] += c2.x * w; acc[9] += c2.y * w; acc[10] += c2.z * w; acc[11] += c2.w * w; acc[12] += c3.x * w; acc[13] += c3.y * w; acc[14] += c3.z * w; acc[15] += c3.w * w;
    }
    int* mod = (int*)(F.ws + WS_MOD);
    const float bb = (kc == 0) ? bada[n] : 0.f;
#pragma unroll
    for (int b = 0; b < 16; ++b) atomicAdd(mod + b * DIN + n, (int)rintf((acc[b] + bb) * 16777216.0f));
    LDS_WAIT(); asm volatile("" ::: "memory");
}
__device__ __forceinline__ void p0_quant_expert(Frame& F, int e) {
    const int lane = F.lane;
    const GAS f32x4* sd = (const GAS f32x4*)(F.in[19] + (size_t)e * D) + 4 * lane;
    const GAS f32x4* su = (const GAS f32x4*)(F.in[20] + (size_t)e * D) + 4 * lane;
    f32x4 vd[4], vu[4]; float ssd = 0.f, ssu = 0.f;
#pragma unroll
    for (int j = 0; j < 4; ++j) { vd[j] = sd[j]; vu[j] = su[j]; }
#pragma unroll
    for (int j = 0; j < 4; ++j) { ssd += (vd[j].x * vd[j].x + vd[j].y * vd[j].y) + (vd[j].z * vd[j].z + vd[j].w * vd[j].w); ssu += (vu[j].x * vu[j].x + vu[j].y * vu[j].y) + (vu[j].z * vu[j].z + vu[j].w * vu[j].w); }
#pragma unroll
    for (int o = 1; o < 64; o <<= 1) { ssd += __shfl_xor(ssd, o); ssu += __shfl_xor(ssu, o); }
    const float stepd = fmaxf(0.3352f * sqrtf(ssd * (1.f / D)), 1e-30f), stepu = fmaxf(0.48f * sqrtf(ssu * (1.f / D)), 1e-30f), invd = 1.0f / stepd, invu = 1.0f / stepu;
    v4u w;
#pragma unroll
    for (int k = 0; k < 2; ++k) { unsigned ad = 0u, au = 0u;
#pragma unroll
        for (int j = 0; j < 8; ++j) {
            { const float x = vd[2 * k + (j >> 2)][j & 3] * invd; int u = (int)floorf(x) + 8; u = u < 0 ? 0 : (u > 15 ? 15 : u); ad |= ((unsigned)u ^ 8u) << (4 * j); }
            { const float x = vu[2 * k + (j >> 2)][j & 3] * invu, a = fabsf(x);
              unsigned code = (a < 0.25f) ? 0u : (a < 0.75f) ? 1u : (a < 1.25f) ? 2u : (a < 1.75f) ? 3u : (a < 2.5f) ? 4u : (a < 3.5f) ? 5u : (a < 5.0f) ? 6u : 7u; if (x < 0.f) code |= 8u; au |= code << (4 * j); } }
        if (k == 0) { w.x = ad; w.z = au; } else { w.y = ad; w.w = au; } }
    *(GAS v4u*)(F.ws + WS_EXP8 + (size_t)e * 1024 + 16 * lane) = w;
    if (lane == 0) { ((float*)(F.ws + WS_SCALES))[2 * e] = stepd; ((float*)(F.ws + WS_SCALES))[2 * e + 1] = stepu; }
}
__device__ __forceinline__ void p0a_prologue(Frame& F) {
    LAS float* scr = (LAS float*)(F.lds + F.wave * 16384);
    const int gw = F.vcu * NWAVES + F.wave, NGW = F.G * NWAVES;
    constexpr int I_MOD = 768, I_IN = (D / 64) * (DIN / 32), I_OUT = (D / 64) * (D / 32), I_WQ = (D / 64) * (DQ2 / 32), I_PW = (256 / 64) * (256 / 32), I_KEYS = 2 * 131072 / 512;
    constexpr int I_EXP = 16384;
    constexpr int NITEMS = I_MOD + I_IN + I_OUT + I_WQ + 4 * I_PW + I_KEYS + I_EXP;
    constexpr int NLIGHT = NITEMS - I_MOD, NH = I_MOD, LH = 8 * NH;
    const bool heavy = F.wave < 3 && F.G * 3 == NH;
    const int hidx = F.vcu * 3 + F.wave, lidx = heavy ? 0 : (F.G * 3 == NH ? F.vcu * 5 + (F.wave - 3) : gw), nl = (F.G * 3 == NH) ? F.G * 5 : NGW;
    if (heavy) p0_mod_item(F, hidx, scr);
    if (F.G * 3 != NH) { for (int it = gw; it < I_MOD; it += NGW) p0_mod_item(F, it, scr); }
    const int first = heavy ? hidx : ((F.G * 3 == NH) ? LH + lidx : gw), step = heavy ? NH : nl, lim = heavy ? LH : NLIGHT;
    for (int it = first; it < lim; it += step) {
        int r = it;
        if (r < I_IN) { p0_transpose_item(F.in[5], D, DIN, (bf16*)(F.ws + WS_WIN), 0, scr, r, F.lane); continue; } r -= I_IN;
        if (r < I_OUT) { p0_transpose_item(F.in[14], D, D, (bf16*)(F.ws + WS_WOUT), 0, scr, r, F.lane); continue; } r -= I_OUT;
        if (r < I_WQ) { p0_transpose_item(F.in[16], D, DQ2, (bf16*)(F.ws + WS_WQ), 0, scr, r, F.lane); continue; } r -= I_WQ;
        if (r < 4 * I_PW) { const int g = r / I_PW; p0_transpose_item(F.in[12] + (size_t)g * 65536, 256, 256, (bf16*)(F.ws + WS_WPOOL) + (size_t)g * 65536, 0, scr, r % I_PW, F.lane, F.in[13] + g * 256); continue; } r -= 4 * I_PW;
        if (r >= I_KEYS) { p0_quant_expert(F, r - I_KEYS); continue; }
        { const int e0 = r * 512 + F.lane * 8; const float* src = (e0 < 131072) ? (F.in[17] + e0) : (F.in[18] + (e0 - 131072));
          const f32x4 a = *(const f32x4*)src, b = *(const f32x4*)(src + 4);
          v4u o; o.x = pk2(a[0], a[1]); o.y = pk2(a[2], a[3]); o.z = pk2(b[0], b[1]); o.w = pk2(b[2], b[3]);
          const int hh = e0 >> 14, key = (e0 >> 7) & 127, d0 = e0 & 127;
          *(GAS v4u*)((bf16*)(F.ws + WS_KEYS) + (((hh * 4 + (key >> 5)) * 8 + (d0 >> 4)) * 512 + (((d0 >> 3) & 1) * 32 + (key & 31)) * 8)) = o; }
    }
}
__device__ __forceinline__ f32x4 ld4bf(const bf16* p) { const unsigned long long w = *(const unsigned long long*)p; const unsigned lo = (unsigned)w, hi = (unsigned)(w >> 32); return (f32x4){bflo(lo), bfhi(lo), bflo(hi), bfhi(hi)}; }
template <bool SRC_BF16> __device__ __forceinline__ void norm_mod_rows_t(Frame& F, const void* srcv, const float* nw, int sh_off, int sc_off, bf16* dst, float eps) {
    const int gw = F.vcu * NWAVES + F.wave, NGW = F.G * NWAVES;
    const float* mod = (const float*)(F.ws + WS_MODF);
    for (int m0 = gw; m0 < M; m0 += 2 * NGW) {
        const int m1 = m0 + NGW;
        f32x4 v0[4], v1[4]; float s0 = 0.f, s1 = 0.f;
#pragma unroll
        for (int j = 0; j < 4; ++j) {
            if (SRC_BF16) { v0[j] = ld4bf((const bf16*)srcv + (size_t)m0 * D + 4 * F.lane + 256 * j); v1[j] = ld4bf((const bf16*)srcv + (size_t)m1 * D + 4 * F.lane + 256 * j); }
            else { v0[j] = *((const GAS f32x4*)((const float*)srcv + (size_t)m0 * D) + F.lane + 64 * j); v1[j] = *((const GAS f32x4*)((const float*)srcv + (size_t)m1 * D) + F.lane + 64 * j); } }
#pragma unroll
        for (int j = 0; j < 4; ++j) { s0 += (v0[j].x * v0[j].x + v0[j].y * v0[j].y) + (v0[j].z * v0[j].z + v0[j].w * v0[j].w); s1 += (v1[j].x * v1[j].x + v1[j].y * v1[j].y) + (v1[j].z * v1[j].z + v1[j].w * v1[j].w); }
#pragma unroll
        for (int o = 1; o < 64; o <<= 1) { s0 += __shfl_xor(s0, o); s1 += __shfl_xor(s1, o); }
        const float r0 = 1.0f / sqrtf(s0 * (1.f / D) + eps), r1 = 1.0f / sqrtf(s1 * (1.f / D) + eps);
        const int b0 = m0 >> 11, b1 = m1 >> 11;
        GAS unsigned long long* o0 = (GAS unsigned long long*)(dst + (size_t)m0 * D) + F.lane; GAS unsigned long long* o1 = (GAS unsigned long long*)(dst + (size_t)m1 * D) + F.lane;
#pragma unroll
        for (int j = 0; j < 4; ++j) { const int col = 4 * F.lane + 256 * j; const f32x4 w = *(const f32x4*)(nw + col);
            { const f32x4 sc = *(const f32x4*)(mod + b0 * DIN + sc_off + col), sh = *(const f32x4*)(mod + b0 * DIN + sh_off + col); const f32x4 hq = v0[j] * r0 * w * (sc + 1.0f) + sh;
              o0[64 * j] = (unsigned long long)pk2(hq.x, hq.y) | ((unsigned long long)pk2(hq.z, hq.w) << 32); }
            { const f32x4 sc = *(const f32x4*)(mod + b1 * DIN + sc_off + col), sh = *(const f32x4*)(mod + b1 * DIN + sh_off + col); const f32x4 hq = v1[j] * r1 * w * (sc + 1.0f) + sh;
              o1[64 * j] = (unsigned long long)pk2(hq.x, hq.y) | ((unsigned long long)pk2(hq.z, hq.w) << 32); } }
    }
}
__device__ __forceinline__ void p0b_rows(Frame& F, bf16* dst) {
    LAS float* ms = (LAS float*)F.lds;
    const int b = F.vcu >> 4; int* mi = (int*)(F.ws + WS_MOD) + b * DIN; float* mf = (float*)(F.ws + WS_MODF) + b * DIN;
    for (int i = F.tid; i < 2048; i += NWAVES * 64) ms[i] = (float)__hip_atomic_fetch_add(mi + i, 0, __ATOMIC_RELAXED, __HIP_MEMORY_SCOPE_AGENT) * (1.0f / 16777216.0f);
    { const int seg = (F.vcu & 15) * 384; if (F.tid < 384) mf[seg + F.tid] = (float)__hip_atomic_fetch_add(mi + seg + F.tid, 0, __ATOMIC_RELAXED, __HIP_MEMORY_SCOPE_AGENT) * (1.0f / 16777216.0f); }
    __syncthreads();
    const float* src = F.in[0]; const float* nw = F.in[4];
#pragma unroll 1
    for (int k = 0; k < 16; k += 2) {
        const int m0 = F.vcu * 128 + F.wave + 8 * k, m1 = m0 + 8;
        f32x4 v0[4], v1[4]; float s0 = 0.f, s1 = 0.f;
#pragma unroll
        for (int j = 0; j < 4; ++j) { v0[j] = *((const GAS f32x4*)(src + (size_t)m0 * D) + F.lane + 64 * j); v1[j] = *((const GAS f32x4*)(src + (size_t)m1 * D) + F.lane + 64 * j); }
#pragma unroll
        for (int j = 0; j < 4; ++j) { s0 += (v0[j].x * v0[j].x + v0[j].y * v0[j].y) + (v0[j].z * v0[j].z + v0[j].w * v0[j].w); s1 += (v1[j].x * v1[j].x + v1[j].y * v1[j].y) + (v1[j].z * v1[j].z + v1[j].w * v1[j].w); }
#pragma unroll
        for (int o = 1; o < 64; o <<= 1) { s0 += __shfl_xor(s0, o); s1 += __shfl_xor(s1, o); }
        const float r0 = 1.0f / sqrtf(s0 * (1.f / D) + 1e-6f), r1 = 1.0f / sqrtf(s1 * (1.f / D) + 1e-6f);
        GAS unsigned long long* o0 = (GAS unsigned long long*)(dst + (size_t)m0 * D) + F.lane; GAS unsigned long long* o1 = (GAS unsigned long long*)(dst + (size_t)m1 * D) + F.lane;
#pragma unroll
        for (int j = 0; j < 4; ++j) { const int col = 4 * F.lane + 256 * j; const f32x4 w = *(const f32x4*)(nw + col);
            const f32x4 sh = *(const LAS f32x4*)(ms + col), sc = *(const LAS f32x4*)(ms + 1024 + col);
            { const f32x4 hq = v0[j] * r0 * w * (sc + 1.0f) + sh; o0[64 * j] = (unsigned long long)pk2(hq.x, hq.y) | ((unsigned long long)pk2(hq.z, hq.w) << 32); }
            { const f32x4 hq = v1[j] * r1 * w * (sc + 1.0f) + sh; o1[64 * j] = (unsigned long long)pk2(hq.x, hq.y) | ((unsigned long long)pk2(hq.z, hq.w) << 32); } }
    }
}
__device__ __forceinline__ void fill_bias_table2(Frame& F, LAS float* tb, int h) {
    const float* rb = F.in[11];
    for (int i = F.tid; i < 640; i += NWAVES * 64) { const int dist = i - 256;
        float v;
        if (dist < 0) v = -INFINITY; else if (dist >= 128) v = 0.f;
        else { int bk = dist; if (dist >= 16) { bk = 16 + (int)(log2f((float)dist * (1.f / 16.f)) * (16.f / 3.f)); if (bk > 31) bk = 31; } v = (rb[bk * 8 + h] - rb[31 * 8 + h]) * LOG2E; }
        tb[i] = v; }
}
template <int W> __device__ __forceinline__ void pool_item(const bf16* __restrict__ P, bf16* __restrict__ PO, int b, int chunk, int g, int lane) {
    const int t0 = chunk * 64, col = g * 256 + lane * 4; const size_t rowb = (size_t)b * SEQ;
    f32x4 ring[16], nw[16];
#pragma unroll
    for (int i = 0; i < 16; ++i) { const int t = t0 - 16 + i; ring[i] = (t >= 0) ? ld4bf(P + (rowb + t) * D + col) : (f32x4){0.f, 0.f, 0.f, 0.f}; }
    for (int blk = 0; blk < 4; ++blk) {
#pragma unroll
        for (int i = 0; i < 16; ++i) nw[i] = ld4bf(P + (rowb + t0 + blk * 16 + i) * D + col);
#pragma unroll
        for (int i = 0; i < 16; ++i) { const int t = t0 + blk * 16 + i;
            f32x4 s = nw[i];
#pragma unroll
            for (int j = 1; j < W; ++j) s += (i - j >= 0) ? nw[i - j] : ring[16 + i - j];
            const int cnt = (t + 1 < W) ? (t + 1) : W;
            const f32x4 r = s * (1.0f / (float)cnt) - nw[i];
            *(unsigned long long*)(PO + (rowb + t) * D + col) = (unsigned long long)pk2(r.x, r.y) | ((unsigned long long)pk2(r.z, r.w) << 32); }
#pragma unroll
        for (int i = 0; i < 16; ++i) ring[i] = nw[i];
    }
}
typedef short rbf16x8 __attribute__((ext_vector_type(8)));
typedef float rf32x16 __attribute__((ext_vector_type(16)));
__device__ __forceinline__ void ce_desc(float& a, float& b) { const float hi = __builtin_fmaxf(a, b), lo = __builtin_fminf(a, b); a = hi; b = lo; }
__device__ __forceinline__ void bitonic_merge16_desc(float (&v)[16]) {
#pragma unroll
    for (int j = 8; j > 0; j >>= 1)
#pragma unroll
        for (int i = 0; i < 16; ++i) { const int l = i ^ j; if (l > i) ce_desc(v[i], v[l]); }
}
__device__ __forceinline__ void sort16_desc(float (&v)[16]) {
#pragma unroll
    for (int k = 2; k <= 16; k <<= 1)
#pragma unroll
        for (int j = k >> 1; j > 0; j >>= 1)
#pragma unroll
            for (int i = 0; i < 16; ++i) { const int l = i ^ j; if (l > i) { if ((i & k) == 0) ce_desc(v[i], v[l]); else ce_desc(v[l], v[i]); } }
}
__device__ __forceinline__ void merge_top16(float (&a)[16], const float (&b)[16]) {
#pragma unroll
    for (int i = 0; i < 16; ++i) a[i] = __builtin_fmaxf(a[i], b[15 - i]);
    bitonic_merge16_desc(a);
}
__device__ __forceinline__ float pack_idx(float s, unsigned keepmask, unsigned idx) { return __builtin_bit_cast(float, (__builtin_bit_cast(unsigned, s) & keepmask) | idx); }
__device__ __forceinline__ void fold_block(const rf32x16& acc, int blk, int hi, float (&top)[16]) {
    if (blk == 0) {
#pragma unroll
        for (int r = 0; r < 16; ++r) top[r] = pack_idx(acc[r], 0xFFFFFF80u, (unsigned)((r & 3) + 8 * (r >> 2)) + 4u * (unsigned)hi);
        sort16_desc(top);
    } else {
        float g[16];
#pragma unroll
        for (int r = 0; r < 16; ++r) g[r] = pack_idx(acc[r], 0xFFFFFF80u, (unsigned)(32 * blk + (r & 3) + 8 * (r >> 2)) + 4u * (unsigned)hi);
        sort16_desc(g); merge_top16(top, g);
    }
}
__device__ __forceinline__ void merge_pair(float (&top)[16], int hi) {
    float o[16];
#pragma unroll
    for (int i = 0; i < 16; ++i) { const unsigned u = __builtin_bit_cast(unsigned, top[i]); auto rr = __builtin_amdgcn_permlane32_swap(u, u, false, false); o[i] = __builtin_bit_cast(float, hi ? rr[0] : rr[1]); }
    merge_top16(top, o);
}
typedef float f32x2g __attribute__((ext_vector_type(2)));
__host__ __device__ constexpr int cand_pos(int i, int j) { int p = 0; for (int a = 0; a < 16; ++a) for (int b = 0; b < 16; ++b) { if (a == i && b == j) return p; if ((a + 1) * (b + 1) <= 16) ++p; } return p; }
static_assert(cand_pos(15, 0) == 49, "50 candidate pairs");
__device__ __forceinline__ void retrieval_mfma(Frame& F, const bf16* Q2, const bf16* KEYS, int* SELI, float* SELG, int tt0, int tt1) {
    const int h = F.wave;
    const __amdgpu_buffer_rsrc_t rq = __builtin_amdgcn_make_buffer_rsrc((void*)Q2, (short)0, M * DQ2 * 2, 0x00020000);
    const __amdgpu_buffer_rsrc_t rk = __builtin_amdgcn_make_buffer_rsrc((void*)KEYS, (short)0, 2 * 8 * 128 * 128 * 2, 0x00020000);
#pragma unroll 1
    for (int tt = tt0; tt < tt1; ++tt) {
        const int T0 = F.vcu * 128 + tt * 32;
        int lane = F.lane; asm volatile("" : "+v"(lane));
        const int r32 = lane & 31, hi = lane >> 5;
        float v1[16], v2[16];
#pragma unroll
        for (int half = 0; half < 2; ++half) {
            const int qoff = (((T0 >> 5) * 8 + h) * 2 + half) * 8192 + lane * 16;
            const int koff = lane * 16, ksoff = (half * 8 + h) * 128 * 128 * 2;
            rbf16x8 bq[8];
#pragma unroll
            for (int ks = 0; ks < 8; ++ks) bq[ks] = __builtin_bit_cast(rbf16x8, __builtin_amdgcn_raw_buffer_load_b128(rq, qoff + ks * 1024, 0, 0));
            rbf16x8 ak[2][8];
#pragma unroll
            for (int ks = 0; ks < 8; ++ks) ak[0][ks] = __builtin_bit_cast(rbf16x8, __builtin_amdgcn_raw_buffer_load_b128(rk, koff + ks * 1024, ksoff, 0));
#pragma unroll
            for (int blk = 0; blk < 4; ++blk) {
                if (blk < 3) {
#pragma unroll
                    for (int ks = 0; ks < 8; ++ks) ak[(blk + 1) & 1][ks] = __builtin_bit_cast(rbf16x8, __builtin_amdgcn_raw_buffer_load_b128(rk, koff + (blk + 1) * 8192 + ks * 1024, ksoff, 0));
                }
                rf32x16 acc = (rf32x16){0.f, 0.f, 0.f, 0.f, 0.f, 0.f, 0.f, 0.f, 0.f, 0.f, 0.f, 0.f, 0.f, 0.f, 0.f, 0.f};
#pragma unroll
                for (int ks = 0; ks < 8; ++ks) acc = __builtin_amdgcn_mfma_f32_32x32x16_bf16(ak[blk & 1][ks], bq[ks], acc, 0, 0, 0);
                if (half == 0) fold_block(acc, blk, hi, v1); else fold_block(acc, blk, hi, v2);
                asm volatile("" ::: "memory");
            }
            if (half == 0) merge_pair(v1, hi); else merge_pair(v2, hi);
        }
        float c0[16], c1[16], c2[16], c3[16];
#pragma unroll
        for (int i = 0; i < 16; ++i)
#pragma unroll
            for (int j = 0; j < 16; ++j) if ((i + 1) * (j + 1) <= 16) {
                const int p = cand_pos(i, j);
                const unsigned e = ((__builtin_bit_cast(unsigned, v1[i]) & 0x7Fu) << 7) | (__builtin_bit_cast(unsigned, v2[j]) & 0x7Fu);
                const float sv = pack_idx(v1[i] + v2[j], 0xFFFFC000u, e);
                if (p < 16) c0[p & 15] = sv; else if (p < 32) c1[p & 15] = sv; else if (p < 48) c2[p & 15] = sv; else c3[p & 15] = sv; }
#pragma unroll
        for (int q = 2; q < 16; ++q) c3[q] = -INFINITY;
        sort16_desc(c0); sort16_desc(c1); sort16_desc(c2); sort16_desc(c3);
        merge_top16(c0, c1); merge_top16(c2, c3); merge_top16(c0, c2);
        float ev[16]; float sum = 0.f;
#pragma unroll
        for (int k = 0; k < 16; ++k) { ev[k] = __expf(c0[k] - c0[0]); sum += ev[k]; }
        const float inv = 1.0f / sum;
        const size_t o = (size_t)(T0 + r32) * NSEL + h * 16;
        const float* SC = (const float*)(F.ws + WS_SCALES); float* SELD = (float*)(F.ws + WS_SELD);
        { unsigned e8[8]; float g8[8];
#pragma unroll
          for (int k = 0; k < 8; ++k) { e8[k] = __builtin_bit_cast(unsigned, hi ? c0[8 + k] : c0[k]) & 0x3FFFu; g8[k] = (hi ? ev[8 + k] : ev[k]) * inv; }
          f32x2g sc[8];
#pragma unroll
          for (int k = 0; k < 8; ++k) sc[k] = *(const f32x2g*)(SC + 2 * e8[k]);
          const size_t o8 = o + 8 * hi;
          *(v4u*)(SELI + o8) = (v4u){e8[0], e8[1], e8[2], e8[3]}; *(v4u*)(SELI + o8 + 4) = (v4u){e8[4], e8[5], e8[6], e8[7]};
          *(f32x4*)(SELD + o8) = (f32x4){sc[0].x, sc[1].x, sc[2].x, sc[3].x}; *(f32x4*)(SELD + o8 + 4) = (f32x4){sc[4].x, sc[5].x, sc[6].x, sc[7].x};
          *(f32x4*)(SELG + o8) = (f32x4){g8[0] * sc[0].y, g8[1] * sc[1].y, g8[2] * sc[2].y, g8[3] * sc[3].y}; *(f32x4*)(SELG + o8 + 4) = (f32x4){g8[4] * sc[4].y, g8[5] * sc[5].y, g8[6] * sc[6].y, g8[7] * sc[7].y}; }
    }
}
__device__ __forceinline__ float ub0(unsigned w) { return (float)(w & 0xffu); }
__device__ __forceinline__ float ub1(unsigned w) { return (float)((w >> 8) & 0xffu); }
__device__ __forceinline__ float ub2(unsigned w) { return (float)((w >> 16) & 0xffu); }
__device__ __forceinline__ float ub3(unsigned w) { return (float)(w >> 24); }
__device__ __forceinline__ float gelu1(float v) {
    const float av = fabsf(v), t = __builtin_amdgcn_rcpf(av * 0.2316418882f + 1.0f);
    float q = t * 0.5307027145f + (-0.7265760135f); q = q * t + 0.7107068705f; q = q * t + (-0.142248368f); q = q * t + 0.127414796f; q = q * t;
    const float e = __builtin_amdgcn_exp2f((v * v) * (-0.72134752044f)), m = v * (q * e);
    return v < 0.f ? m : v - m;
}
__device__ __forceinline__ int xch32(int v, int lane) { auto rr = __builtin_amdgcn_permlane32_swap((unsigned)v, (unsigned)v, false, false); return (int)((lane & 32) ? rr[0] : rr[1]); }
__device__ __forceinline__ int xch16(int v, int lane) { auto rr = __builtin_amdgcn_permlane16_swap((unsigned)v, (unsigned)v, false, false); return (int)((lane & 16) ? rr[0] : rr[1]); }
__device__ __forceinline__ int xch8(int v) { return __builtin_amdgcn_update_dpp(0, v, 0x128, 0xf, 0xf, false); }
__device__ __forceinline__ int red8i(int v) { v += __builtin_amdgcn_update_dpp(0, v, 0x141, 0xf, 0xf, false);
    v += __builtin_amdgcn_update_dpp(0, v, 0x4E, 0xf, 0xf, false); v += __builtin_amdgcn_update_dpp(0, v, 0xB1, 0xf, 0xf, false); return v; }
typedef unsigned u32x2g __attribute__((ext_vector_type(2)));
typedef int v8i32_t __attribute__((ext_vector_type(8)));
#define PEER4_COMPUTE(c, RB, GG, DD) do { int p[8]; \
        _Pragma("unroll") for (int i = 0; i < 8; ++i) { const int w0 = (int)RB[i].x, w1 = (int)RB[i].y; int dh, dl; \
            asm("v_dot8_i32_i4 %0, %1, %2, 0" : "=v"(dh) : "v"(w0), "v"(hA0)); asm("v_dot8_i32_i4 %0, %1, %2, %0" : "+v"(dh) : "v"(w1), "v"(hA1)); \
            asm("v_dot8_i32_i4 %0, %1, %2, 0" : "=v"(dl) : "v"(w0), "v"(hB0)); asm("v_dot8_i32_i4 %0, %1, %2, %0" : "+v"(dl) : "v"(w1), "v"(hB1)); p[i] = (dh << 4) + dl; } \
          \
        int q4[4], q2[2], q1; \
        _Pragma("unroll") for (int i = 0; i < 4; ++i) { auto r_ = __builtin_amdgcn_permlane32_swap((unsigned)p[i], (unsigned)p[4 + i], false, false); q4[i] = (int)(r_[0] + r_[1]); } \
        _Pragma("unroll") for (int i = 0; i < 2; ++i) { auto r_ = __builtin_amdgcn_permlane16_swap((unsigned)q4[i], (unsigned)q4[2 + i], false, false); q2[i] = (int)(r_[0] + r_[1]); } \
        { const int keep = (lane & 8) ? q2[1] : q2[0], send = (lane & 8) ? q2[0] : q2[1]; q1 = keep + xch8(send); } \
        q1 = red8i(q1); \
        const float wv = GG * gelu1(DD * hscale * ((float)q1 - hoff));     \
        const float ws_ = __builtin_amdgcn_fmed3f(wv * 512.0f, -448.0f, 448.0f); \
        const int wq_ = __builtin_amdgcn_cvt_pk_fp8_f32(ws_, ws_, 0, false); \
        _Pragma("unroll") for (int i = 0; i < 8; i += 2) { \
            const unsigned ci = ((unsigned)__builtin_amdgcn_ds_bpermute(abp_ + 32 * i, wq_) & 0xffu) << ash;     \
            v8i32_t av_; av_[0] = am0 ? (int)ci : 0; av_[1] = am1 ? (int)ci : 0; av_[2] = am2 ? (int)ci : 0; av_[3] = am3 ? (int)ci : 0; av_[4] = am4 ? (int)ci : 0; av_[5] = am5 ? (int)ci : 0; av_[6] = am6 ? (int)ci : 0; av_[7] = am7 ? (int)ci : 0; \
            const v8i32_t bv_ = (v8i32_t){(int)RB[i].z, (int)RB[i].w, (int)RB[i + 1].z, (int)RB[i + 1].w, 0, 0, 0, 0}; \
            acc = __builtin_amdgcn_mfma_scale_f32_32x32x64_f8f6f4(av_, bv_, acc, 0  , 4  , 0, 118  , 0, 127); } } while (0)
#define PEERS_LOAD(tok, cc, EA, EB, RB, GG, DD) do { const int cc_ = (cc); const size_t so_ = (size_t)(tok) * NSEL + cc_ * 8 + isel; GG = SELG[so_]; DD = SELD[so_]; \
        const int Ec_ = (cc_ < 8) ? (EA) : (EB); const int sb_ = (cc_ & 7) * 8; \
        _Pragma("unroll") for (int i = 0; i < 8; ++i) { const int e = __builtin_amdgcn_readlane(Ec_, sb_ + i); \
        const v4u rw = __builtin_bit_cast(v4u, __builtin_amdgcn_raw_buffer_load_b128(rexp, 16 * lane, e * 1024, 0)); RB[i] = rw; } } while (0)
#define PEERS_PROLOGUE() do { float h[16]; \
        { const v4u w0 = hr0, w1 = hr1; \
          h[0] = bflo(w0.x); h[1] = bfhi(w0.x); h[2] = bflo(w0.y); h[3] = bfhi(w0.y); h[4] = bflo(w0.z); h[5] = bfhi(w0.z); h[6] = bflo(w0.w); h[7] = bfhi(w0.w); \
          h[8] = bflo(w1.x); h[9] = bfhi(w1.x); h[10] = bflo(w1.y); h[11] = bfhi(w1.y); h[12] = bflo(w1.z); h[13] = bfhi(w1.z); h[14] = bflo(w1.w); h[15] = bfhi(w1.w); } \
        float am = 0.f; \
        _Pragma("unroll") for (int i = 0; i < 16; ++i) am = fmaxf(am, fabsf(h[i])); \
        _Pragma("unroll") for (int i = 0; i < 16; ++i) acc[i] = 0.f; \
        _Pragma("unroll") for (int o = 1; o < 64; o <<= 1) am = fmaxf(am, __shfl_xor(am, o)); \
        am = fmaxf(am, 1e-30f); \
        const float hinv = 119.0f / am; hscale = am * (1.0f / 119.0f); \
          \
          \
        int hsum = 0; hA0 = 0u; hA1 = 0u; hB0 = 0u; hB1 = 0u; \
        _Pragma("unroll") for (int i = 0; i < 16; ++i) { const int hq = (int)rintf(h[i] * hinv); hsum += hq; const int bd = ((hq + 8) & 15) - 8, ad = (hq - bd) >> 4; \
            if (i < 8) { hA0 |= (unsigned)(ad & 15) << (4 * i); hB0 |= (unsigned)(bd & 15) << (4 * i); } else { hA1 |= (unsigned)(ad & 15) << (4 * (i - 8)); hB1 |= (unsigned)(bd & 15) << (4 * (i - 8)); } } \
        _Pragma("unroll") for (int o = 1; o < 64; o <<= 1) hsum += __shfl_xor(hsum, o); \
        hoff = -0.5f * (float)hsum;                   \
          \
        xr0 = *(const v4u*)(X1 + (size_t)t * D + 16 * lane); xr1 = *(const v4u*)(X1 + (size_t)t * D + 16 * lane + 8); \
        if (t + NWAVES < tend) { const int tn_ = t + NWAVES; En0 = SELI[(size_t)tn_ * NSEL + lane]; En1 = SELI[(size_t)tn_ * NSEL + 64 + lane]; \
            hr0 = *(const v4u*)(H2 + (size_t)tn_ * D + 16 * lane); hr1 = *(const v4u*)(H2 + (size_t)tn_ * D + 16 * lane + 8); } } while (0)
#define PEERS_EPILOGUE() do { float x2[16]; float ss = 0.f; \
        _Pragma("unroll") for (int j = 0; j < 4; ++j) { const int col = 16 * lane + 4 * j; const unsigned wlo = (j < 2) ? (j == 0 ? xr0.x : xr0.z) : (j == 2 ? xr1.x : xr1.z), whi = (j < 2) ? (j == 0 ? xr0.y : xr0.w) : (j == 2 ? xr1.y : xr1.w); \
            const f32x4 xv = (f32x4){bflo(wlo), bfhi(wlo), bflo(whi), bfhi(whi)}, g2 = *(const LAS f32x4*)(g2s + col); \
            x2[4 * j] = xv.x + g2.x * acc[4 * j]; x2[4 * j + 1] = xv.y + g2.y * acc[4 * j + 1]; x2[4 * j + 2] = xv.z + g2.z * acc[4 * j + 2]; x2[4 * j + 3] = xv.w + g2.w * acc[4 * j + 3]; \
            ss += (x2[4 * j] * x2[4 * j] + x2[4 * j + 1] * x2[4 * j + 1]) + (x2[4 * j + 2] * x2[4 * j + 2] + x2[4 * j + 3] * x2[4 * j + 3]); } \
        const float rr = 1.0f / sqrtf(wave_sum(ss) * (1.f / D) + 1e-6f); \
        _Pragma("unroll") for (int j = 0; j < 4; ++j) { const int col = 16 * lane + 4 * j; const f32x4 w = *(const LAS f32x4*)(nfws + col); \
            *(f32x4*)(OUT + (size_t)t * D + col) = (f32x4){x2[4 * j] * rr * w.x, x2[4 * j + 1] * rr * w.y, x2[4 * j + 2] * rr * w.z, x2[4 * j + 3] * rr * w.w}; } } while (0)
#define PEERS_SLOT(CRB, CG, CD, LRB, LG, LD) do { \
        if ((n & 15) == 0) { if (n > 0) { PEERS_EPILOGUE(); t += NWAVES; E0 = En0; E1 = En1; } PEERS_PROLOGUE(); } \
        { const int n2 = n + 2; if (n2 < total) { const bool nx = (n2 >> 4) != (n >> 4); PEERS_LOAD(nx ? t + NWAVES : t, n2 & 15, nx ? En0 : E0, nx ? En1 : E1, LRB, LG, LD); } } \
        PEER4_COMPUTE(0, CRB, CG, CD); ++n; } while (0)
__device__ __forceinline__ void peer_q4(Frame& F, const bf16* H2, const bf16* X1, const int* SELI, const float* SELG, float* OUT, int tfirst, int tend, const LAS float* g2s, const LAS float* nfws) {
    const int lane = F.lane, isel = (lane >> 3) & 7;
    const float* SELD = (const float*)(F.ws + WS_SELD);
    const __amdgpu_buffer_rsrc_t rexp = __builtin_amdgcn_make_buffer_rsrc((void*)(F.ws + WS_EXP8), (short)0, 16384 * 1024, 0x00020000);
    if (tfirst >= tend) return;
    const int total = ((tend - tfirst + NWAVES - 1) / NWAVES) * (NSEL / 8);
    int t = tfirst, n = 0;
    int E0 = SELI[(size_t)tfirst * NSEL + lane], E1 = SELI[(size_t)tfirst * NSEL + 64 + lane], En0 = 0, En1 = 0;
    v4u hr0 = *(const v4u*)(H2 + (size_t)tfirst * D + 16 * lane), hr1 = *(const v4u*)(H2 + (size_t)tfirst * D + 16 * lane + 8), xr0, xr1;
    v4u rbA[8], rbB[8], rbC[8]; float gA, sdA, gB, sdB, gC, sdC;
    rf32x16 acc;
    const int mrow_ = lane & 31, cm_ = 4 * (mrow_ >> 3) + (mrow_ & 3); const int aq_ = 4 * ((mrow_ >> 2) & 1) + (cm_ >> 2); const unsigned ash = 8u * (unsigned)(cm_ & 3);
    const int abp_ = (lane >> 5) * 32;
    const bool am0 = aq_ == 0, am1 = aq_ == 1, am2 = aq_ == 2, am3 = aq_ == 3, am4 = aq_ == 4, am5 = aq_ == 5, am6 = aq_ == 6, am7 = aq_ == 7;
    float hscale = 0.f, hoff = 0.f; unsigned hA0 = 0u, hA1 = 0u, hB0 = 0u, hB1 = 0u;
    PEERS_LOAD(tfirst, 0, E0, E1, rbA, gA, sdA); PEERS_LOAD(tfirst, 1, E0, E1, rbB, gB, sdB);
#pragma unroll 1
    while (n < total) {
        PEERS_SLOT(rbA, gA, sdA, rbC, gC, sdC);
        if (n < total) PEERS_SLOT(rbB, gB, sdB, rbA, gA, sdA);
        if (n < total) PEERS_SLOT(rbC, gC, sdC, rbB, gB, sdB);
    }
    PEERS_EPILOGUE();
}

struct Args { const float* in[22]; float* out; unsigned char* ws; };
__global__ void __launch_bounds__(NWAVES * 64, 2) fwd_megakernel(Args args) {
    extern __shared__ __attribute__((aligned(16))) unsigned char lds[];
    Frame F;
    F.lds = (LAS unsigned char*)lds; F.MISC = (volatile LAS unsigned*)(F.lds + MISC_OFF);
    F.tid = threadIdx.x; F.lane = F.tid & 63; F.wave = __builtin_amdgcn_readfirstlane(F.tid >> 6);
    F.G = gridDim.x; { const int bx = blockIdx.x; F.vcu = (F.G % 8 == 0) ? (bx % 8) * (F.G / 8) + bx / 8 : bx; }
#pragma unroll
    for (int i = 0; i < 22; ++i) F.in[i] = args.in[i];
    F.out = args.out; F.ws = args.ws; F.ctl = (gu32*)(args.ws + WS_CTL);
    for (int u = F.tid; u < (LDS_BYTES - LDSCTL_OFF) / 4; u += NWAVES * 64) ((LAS unsigned*)(F.lds + LDSCTL_OFF))[u] = 0u;
    __syncthreads();
    XcdBarrier bar = xcd_barrier_post((unsigned*)(F.ctl + CW_BAR), F.MISC + 8);
    unsigned char* ws = args.ws;
    bf16* XN = (bf16*)(ws + WS_XN); bf16* Qb = (bf16*)(ws + WS_Q); bf16* Kb = (bf16*)(ws + WS_K); bf16* Vb = (bf16*)(ws + WS_V); bf16* Pb = (bf16*)(ws + WS_P);
    bf16* GAb = (bf16*)(ws + WS_GA); bf16* GPb = (bf16*)(ws + WS_GP); bf16* MG = XN;     bf16* Q2 = (bf16*)(ws + WS_Q2);
    bf16* X1 = GAb;
    bf16* POOLED = (bf16*)F.out + (size_t)M * D;
    {
    const float* mod = (const float*)(ws + WS_MODF);
    const int gw = F.vcu * NWAVES + F.wave, NGW = F.G * NWAVES;

    refresh(F); p0a_prologue(F);
    xcd_barrier(bar);
    refresh(F); p0b_rows(F, XN);
    xcd_barrier(bar);
    refresh(F); { pg8::Gemm g{XN, (const bf16*)(ws + WS_WIN), M, DIN, D, D, 0}; pg8::StaticOrder S; S.init(M, DIN, F.G, (int)blockIdx.x);
      pg8::EpiInProj E{Qb, (size_t)(WS_K - WS_Q) / 2, C2};
      pg8::gemm_phase<pg8::EpiInProj, pg8::StaticOrder, true, true>(F.lds, g, S, E); }
    xcd_barrier(bar);
    refresh(F); {
      { LAS float* tb = (LAS float*)(F.lds + attn_body::LDS_TAB);
        fill_bias_table2(F, tb, (F.vcu >> 1) & 7);
        float lam; { const float a = F.in[6][F.lane] * F.in[7][F.lane], bq = F.in[8][F.lane] * F.in[9][F.lane]; lam = __expf(wave_sum(a)) - __expf(wave_sum(bq)) + 0.2f; }
        const attn_body::AttnTensors AT{(const attn_body::bf16*)Qb, (const attn_body::bf16*)Kb, (const attn_body::bf16*)Vb, (const attn_body::bf16*)GAb, (attn_body::bf16*)MG};
        attn_body::attn_phase<8>((char*)lds, AT, F.vcu, (attn_body::lds_fptr)tb, lam, F.in[10]); }
      for (int it = gw; it < BATCH * 32 * 4; it += NGW) { const int g = it & 3, chunk = (it >> 2) & 31, b = it >> 7;
          if (g == 0) pool_item<2>(Pb, POOLED, b, chunk, 0, F.lane); else if (g == 1) pool_item<4>(Pb, POOLED, b, chunk, 1, F.lane);
          else if (g == 2) pool_item<8>(Pb, POOLED, b, chunk, 2, F.lane); else pool_item<16>(Pb, POOLED, b, chunk, 3, F.lane); } }
    xcd_barrier(bar);
    refresh(F); { pg8::Gemm g{POOLED, (const bf16*)(ws + WS_WPOOL), M, D, 256, D, 256}; pg8::StaticOrder S; S.init(M, D, F.G, (int)blockIdx.x);
      pg8::EpiPool E{MG, GPb, D};
      pg8::gemm_phase<pg8::EpiPool, pg8::StaticOrder, true, true>(F.lds, g, S, E); }
    xcd_barrier(bar);
    refresh(F); { pg8::Gemm g{MG, (const bf16*)(ws + WS_WOUT), M, D, D, D, 0}; pg8::StaticOrder S; S.init(M, D, F.G, (int)blockIdx.x);
      pg8::EpiResidBf E{F.in[0], X1, mod + 2048, D, DIN, SEQ};
      pg8::gemm_phase<pg8::EpiResidBf, pg8::StaticOrder, true, true>(F.lds, g, S, E); }
    xcd_barrier(bar);
    refresh(F); norm_mod_rows_t<true>(F, X1, F.in[15], 3072, 4096, XN, 1e-6f);
    xcd_barrier(bar);
    refresh(F); { pg8::Gemm g{XN, (const bf16*)(ws + WS_WQ), M, DQ2, D, D, 0}; pg8::StaticOrder S; S.init(M, DQ2, F.G, (int)blockIdx.x);
      pg8::EpiQFrag E{Q2};
      pg8::gemm_phase<pg8::EpiQFrag, pg8::StaticOrder, true, true>(F.lds, g, S, E); }
    xcd_barrier(bar);
    refresh(F);
    { const bf16* KEYSb = (const bf16*)(ws + WS_KEYS); int* SELIp = (int*)(ws + WS_SELI); float* SELGp = (float*)(ws + WS_SELG);
      LAS float* g2s = (LAS float*)F.lds; LAS float* nfws = g2s + D;
      for (int i = F.tid; i < D; i += NWAVES * 64) { g2s[i] = mod[((F.vcu * 128) >> 11) * DIN + 5120 + i]; nfws[i] = F.in[21][i]; }
#pragma unroll 1
      for (int g = -1; g < 4; ++g) {
#pragma unroll 1
          for (int s = 0; s < 2; ++s) {
              if ((s == 0) == (F.wave < 4)) { if (g < 3) retrieval_mfma(F, Q2, KEYSb, SELIp, SELGp, g + 1, g + 2); }
              else if (g >= 0) peer_q4(F, XN, X1, SELIp, SELGp, F.out, F.vcu * 128 + g * 32 + F.wave, F.vcu * 128 + g * 32 + 32, g2s, nfws);
          }
          VM_WAIT(); __syncthreads();
      } }
    }
}

extern "C" void kernel_launch(void* const* d_in, const int* in_sizes, int n_in, void* d_out, int out_size, void* d_ws, size_t ws_size, hipStream_t stream) {
    static int grid = 0;
    if (grid == 0) {
        if (n_in != 22 || in_sizes[0] != M * D || out_size != M * D || ws_size < WS_END) { fprintf(stderr, "kernel_launch: unexpected shapes/workspace (n_in %d, in0 %d, out %d, ws %zu < %zu); nothing launched\n", n_in, n_in > 0 ? in_sizes[0] : -1, out_size, ws_size, (size_t)WS_END); grid = -1; return; }
        int dev = 0, cus = 0;
        if (hipGetDevice(&dev) != hipSuccess || hipDeviceGetAttribute(&cus, hipDeviceAttributeMultiprocessorCount, dev) != hipSuccess) { grid = -1; return; }
        if (hipFuncSetAttribute((const void*)fwd_megakernel, hipFuncAttributeMaxDynamicSharedMemorySize, LDS_BYTES) != hipSuccess) { fprintf(stderr, "kernel_launch: hipFuncSetAttribute failed\n"); grid = -1; return; }
        int per_cu = 0;
        if (hipOccupancyMaxActiveBlocksPerMultiprocessor(&per_cu, (const void*)fwd_megakernel, NWAVES * 64, LDS_BYTES) != hipSuccess || per_cu < 1) fprintf(stderr, "kernel_launch: occupancy query reports %d\n", per_cu);
        (void)hipGetLastError();
        grid = cus;
    }
    if (grid < 0) return;
    if (hipMemsetAsync((char*)d_ws + WS_CTL, 0, CTL_ZERO_BYTES, stream) != hipSuccess) { fprintf(stderr, "kernel_launch: memset failed\n"); return; }
    Args a{};
    for (int i = 0; i < 22; ++i) a.in[i] = (const float*)d_in[i];
    a.out = (float*)d_out; a.ws = (unsigned char*)d_ws;
    hipLaunchKernelGGL(fwd_megakernel, dim3(grid), dim3(NWAVES * 64), LDS_BYTES, stream, a);
}
```

```cpp
#include <hip/hip_runtime.h>
#include <cstdio>
#include <cstdint>
namespace pg8 {
#define PG8_LAS __attribute__((address_space(3)))
typedef unsigned short bf16_t;
typedef short bf16x8 __attribute__((ext_vector_type(8)));
typedef float f32x4 __attribute__((ext_vector_type(4)));
typedef unsigned u32x4 __attribute__((ext_vector_type(4)));
constexpr int BM = 256, BK = 64, HALF = 128, HTB = HALF * BK * 2  , STAGE_BYTES = 8 * HTB, NXCD = 8, WGM = 8;

__host__ __device__ __forceinline__ int lds_byte(int r, int c) { const int st = (r >> 4) * 2 + (c >> 5), rr = r & 15, cc = c & 31, ob = rr * 64 + cc * 2; return st * 1024 + (ob ^ (((ob >> 9) & 1) << 5)); }
__host__ __device__ __forceinline__ void stage_rc(int b, int& R, int& C) { const int st = b / 1024, sb = b % 1024, swz = sb ^ (((sb >> 9) & 1) << 5); R = (st >> 1) * 16 + swz / 64; C = (st & 1) * 32 + (swz % 64) / 2; }
__host__ __device__ __forceinline__ int perm32(int rho) { const int n = rho >> 4, i = rho & 15; return 8 * (i >> 2) + 4 * n + (i & 3); }

struct Unit { int pm, pn; };
struct Gemm { const bf16_t* A; const bf16_t* Bt; int M, N, K, lda, a_pn; };

struct StaticOrder {
    int nM, nN, nwg, G, c;
    __host__ __device__ void init(int M, int N, int G_, int c_) { nM = M / BM; nN = N / BM; nwg = nM * nN; G = G_; c = c_; }
    __host__ __device__ bool next(int i, Unit& u) const {
        const long L = (long)i * G + c; if (L >= nwg) return false;
        int wgid = (int)L; { const int q = nwg / NXCD, r = nwg % NXCD, xcd = wgid % NXCD, off = wgid / NXCD; wgid = (xcd < r ? xcd * (q + 1) : r * (q + 1) + (xcd - r) * q) + off; }
        const int nig = WGM * nN, gid = wgid / nig, fm = gid * WGM, gsz = (nM - fm) < WGM ? (nM - fm) : WGM;
        u.pm = fm + ((wgid % nig) % gsz); u.pn = (wgid % nig) / gsz; return true;
    }
    __device__ __forceinline__ void a_ready(const Unit&) const {}
    __device__ __forceinline__ void done(const Unit&) const {}
};

__device__ __forceinline__ unsigned cvt_pk_bf16(float lo, float hi) { unsigned r; asm volatile("v_cvt_pk_bf16_f32 %0, %1, %2" : "=v"(r) : "v"(lo), "v"(hi)); return r; }
typedef float f32x2 __attribute__((ext_vector_type(2)));
__device__ __forceinline__ f32x2 gelu_pk(f32x2 v) {
    const f32x2 av = __builtin_elementwise_abs(v), d = av * 0.2316418882f + 1.0f;
    f32x2 t; t.x = __builtin_amdgcn_rcpf(d.x); t.y = __builtin_amdgcn_rcpf(d.y);
    f32x2 q = t * 0.5307027145f + (-0.7265760135f); q = q * t + 0.7107068705f; q = q * t + (-0.142248368f); q = q * t + 0.127414796f; q = q * t;
    const f32x2 s = (v * v) * (-0.72134752044f);
    f32x2 e; e.x = __builtin_amdgcn_exp2f(s.x); e.y = __builtin_amdgcn_exp2f(s.y);
    const f32x2 m = v * (q * e), r = v - m;
    f32x2 o; o.x = v.x < 0.f ? m.x : r.x; o.y = v.y < 0.f ? m.y : r.y; return o;
}

template <int ACT  > struct EpiBf16 {
    static constexpr bool PERM = true, AFTER_DRAIN = false; static_assert(ACT == 0 || ACT == 1, "EpiBf16: ACT is 0 (none) or 1 (gelu_pk)");
    bf16_t* O; int ldc; const float* bias; int split_cols; size_t split_stride; float scale0;
    __device__ __forceinline__ void operator()(const f32x4 (&acc)[2][2][4][2], const Unit& u, int wr, int wc, int fr, int fq) const {
        const int row0 = u.pm * BM + wr * 64 + fr; int colt = u.pn * BM; bf16_t* base = O;
        float sc = 1.f; if (split_cols) { const int t = colt / split_cols; base += (size_t)t * split_stride; colt -= t * split_cols; if (t == 0) sc = scale0; }
        const int col0 = colt + wc * 32 + 8 * fq, bcol0 = u.pn * BM + wc * 32 + 8 * fq;
        f32x4 bv[2][2];
#pragma unroll
        for (int bj = 0; bj < 2; ++bj)
#pragma unroll
            for (int n = 0; n < 2; ++n) bv[bj][n] = bias ? *(const f32x4*)(bias + bcol0 + bj * HALF + 4 * n) : (f32x4){0.f, 0.f, 0.f, 0.f};
#pragma unroll
        for (int ai = 0; ai < 2; ++ai)
#pragma unroll
            for (int m = 0; m < 4; ++m) { bf16_t* rowp = base + (size_t)(row0 + ai * HALF + m * 16) * ldc + col0;
#pragma unroll
                for (int bj = 0; bj < 2; ++bj) { f32x4 v0 = acc[ai][bj][m][0] + bv[bj][0], v1 = acc[ai][bj][m][1] + bv[bj][1];
                    if (ACT == 1) { f32x2 a = gelu_pk((f32x2){v0[0], v0[1]}), b = gelu_pk((f32x2){v0[2], v0[3]}), c = gelu_pk((f32x2){v1[0], v1[1]}), d = gelu_pk((f32x2){v1[2], v1[3]});
                        v0 = (f32x4){a.x, a.y, b.x, b.y}; v1 = (f32x4){c.x, c.y, d.x, d.y}; }
                    v0 = v0 * sc; v1 = v1 * sc; u32x4 w; w.x = cvt_pk_bf16(v0[0], v0[1]); w.y = cvt_pk_bf16(v0[2], v0[3]); w.z = cvt_pk_bf16(v1[0], v1[1]); w.w = cvt_pk_bf16(v1[2], v1[3]);
                    *(u32x4*)(rowp + bj * HALF) = w; } }
    }
};
__device__ __forceinline__ float bf_lo(unsigned w) { return __builtin_bit_cast(float, w << 16); }
__device__ __forceinline__ float bf_hi(unsigned w) { return __builtin_bit_cast(float, w & 0xffff0000u); }
__device__ __forceinline__ float sigmoidf_(float x) { return __builtin_amdgcn_rcpf(1.0f + __builtin_amdgcn_exp2f(-1.4426950408889634f * x)); }
struct EpiPool {
    static constexpr bool PERM = true, AFTER_DRAIN = false;
    bf16_t* MG; const bf16_t* GP; int ldc;
    __device__ __forceinline__ void operator()(const f32x4 (&acc)[2][2][4][2], const Unit& u, int wr, int wc, int fr, int fq) const {
        const int row0 = u.pm * BM + wr * 64 + fr, col0 = u.pn * BM + wc * 32 + 8 * fq;
#pragma unroll
        for (int ai = 0; ai < 2; ++ai)
#pragma unroll
            for (int m = 0; m < 4; ++m) { const size_t ro = (size_t)(row0 + ai * HALF + m * 16) * ldc + col0;
#pragma unroll
                for (int bj = 0; bj < 2; ++bj) {
                    const u32x4 mg = *(const u32x4*)(MG + ro + bj * HALF), gp = *(const u32x4*)(GP + ro + bj * HALF);
                    const f32x4 a0 = acc[ai][bj][m][0], a1 = acc[ai][bj][m][1];
                    u32x4 w;
                    w.x = cvt_pk_bf16(bf_lo(mg.x) + a0[0] * sigmoidf_(bf_lo(gp.x)), bf_hi(mg.x) + a0[1] * sigmoidf_(bf_hi(gp.x)));
                    w.y = cvt_pk_bf16(bf_lo(mg.y) + a0[2] * sigmoidf_(bf_lo(gp.y)), bf_hi(mg.y) + a0[3] * sigmoidf_(bf_hi(gp.y)));
                    w.z = cvt_pk_bf16(bf_lo(mg.z) + a1[0] * sigmoidf_(bf_lo(gp.z)), bf_hi(mg.z) + a1[1] * sigmoidf_(bf_hi(gp.z)));
                    w.w = cvt_pk_bf16(bf_lo(mg.w) + a1[2] * sigmoidf_(bf_lo(gp.w)), bf_hi(mg.w) + a1[3] * sigmoidf_(bf_hi(gp.w)));
                    *(u32x4*)(MG + ro + bj * HALF) = w; }
                asm volatile("" ::: "memory"); }
    }
};
struct EpiResidBf {
    static constexpr bool PERM = true, AFTER_DRAIN = false;
    const float* x; bf16_t* out; const float* gate; int ldc, gpitch, rows_per_b;
    __device__ __forceinline__ void operator()(const f32x4 (&acc)[2][2][4][2], const Unit& u, int wr, int wc, int fr, int fq) const {
        const int row0 = u.pm * BM + wr * 64 + fr, col0 = u.pn * BM + wc * 32 + 8 * fq;
        const float* gb = gate + (size_t)((u.pm * BM) / rows_per_b) * gpitch + col0;
        f32x4 gv[2][2];
#pragma unroll
        for (int bj = 0; bj < 2; ++bj)
#pragma unroll
            for (int n = 0; n < 2; ++n) gv[bj][n] = *(const f32x4*)(gb + bj * HALF + 4 * n);
#pragma unroll
        for (int ai = 0; ai < 2; ++ai)
#pragma unroll
            for (int m = 0; m < 4; ++m) { const size_t ro = (size_t)(row0 + ai * HALF + m * 16) * ldc + col0;
#pragma unroll
                for (int bj = 0; bj < 2; ++bj) { const f32x4 x0 = *(const f32x4*)(x + ro + bj * HALF), x1 = *(const f32x4*)(x + ro + bj * HALF + 4);
                    const f32x4 v0 = x0 + gv[bj][0] * acc[ai][bj][m][0], v1 = x1 + gv[bj][1] * acc[ai][bj][m][1];
                    u32x4 w; w.x = cvt_pk_bf16(v0[0], v0[1]); w.y = cvt_pk_bf16(v0[2], v0[3]); w.z = cvt_pk_bf16(v1[0], v1[1]); w.w = cvt_pk_bf16(v1[2], v1[3]);
                    *(u32x4*)(out + ro + bj * HALF) = w; } }
    }
};
struct EpiQFrag {
    static constexpr bool PERM = true, AFTER_DRAIN = false;
    bf16_t* O;
    __device__ __forceinline__ void operator()(const f32x4 (&acc)[2][2][4][2], const Unit& u, int wr, int wc, int fr, int fq) const {
        const int row0 = u.pm * BM + wr * 64 + fr;
#pragma unroll
        for (int ai = 0; ai < 2; ++ai)
#pragma unroll
            for (int m = 0; m < 4; ++m) { const int r = row0 + ai * HALF + m * 16;
#pragma unroll
                for (int bj = 0; bj < 2; ++bj) { const f32x4 v0 = acc[ai][bj][m][0], v1 = acc[ai][bj][m][1];
                    u32x4 w; w.x = cvt_pk_bf16(v0[0], v0[1]); w.y = cvt_pk_bf16(v0[2], v0[3]); w.z = cvt_pk_bf16(v1[0], v1[1]); w.w = cvt_pk_bf16(v1[2], v1[3]);
                    *(u32x4*)(O + ((size_t)(((r >> 5) * 8 + u.pn) * 2 + bj) * 4096 + (wc * 2 + (fq >> 1)) * 512 + ((fq & 1) * 32 + (r & 31)) * 8)) = w; } }
    }
};
struct EpiInProj {
    static constexpr bool PERM = true, AFTER_DRAIN = false;
    bf16_t* O; size_t stride; float scale0;
    __device__ __forceinline__ void operator()(const f32x4 (&acc)[2][2][4][2], const Unit& u, int wr, int wc, int fr, int fq) const {
        const int row0 = u.pm * BM + wr * 64 + fr; int colt = u.pn * BM; const int t = colt >> 10; colt &= 1023;
        bf16_t* base = O + (size_t)t * stride; const float sc = (t == 0) ? scale0 : 1.f;
        const int col0 = colt + wc * 32 + 8 * fq;
#pragma unroll
        for (int ai = 0; ai < 2; ++ai)
#pragma unroll
            for (int m = 0; m < 4; ++m) { const int r = row0 + ai * HALF + m * 16;
#pragma unroll
                for (int bj = 0; bj < 2; ++bj) { const int c = col0 + bj * HALF; const f32x4 v0 = acc[ai][bj][m][0] * sc, v1 = acc[ai][bj][m][1] * sc;
                    u32x4 w; w.x = cvt_pk_bf16(v0[0], v0[1]); w.y = cvt_pk_bf16(v0[2], v0[3]); w.z = cvt_pk_bf16(v1[0], v1[1]); w.w = cvt_pk_bf16(v1[2], v1[3]);
                    size_t off;
                    if (false) off = (size_t)(((((r >> 11) * 16 + (c >> 6)) * 32 + ((r >> 6) & 31)) * 8 + ((c >> 3) & 7)) * 512 + (r & 63) * 8);
                    else if (false) off = (size_t)((((((r >> 11) * 8 + (c >> 7)) * 32 + ((r >> 6) & 31)) * 4 + ((c >> 5) & 3)) * 64 + (r & 63)) * 32 + (c & 31));
                    else off = (size_t)r * 1024 + c;
                    *(u32x4*)(base + off) = w; } }
    }
};
template <class Epi, class Sched, bool ALIGN_EPI = false, bool SP2 = false>
__device__ __forceinline__ void gemm_phase(PG8_LAS unsigned char* lds, const Gemm g, const Sched& S, const Epi& E) {
    int tid = threadIdx.x; asm volatile("" : "+v"(tid));
    const int wid = __builtin_amdgcn_readfirstlane(tid >> 6), lane = tid & 63, wr = wid >> 2, wc = wid & 3, fr = lane & 15, fq = lane >> 4;
    int K = g.K; asm volatile("" : "+s"(K));
    const int nt = K / BK;
    unsigned voffA[2], voffB[2];
#pragma unroll
    for (int i = 0; i < 2; ++i) { int R, C; stage_rc(tid * 16 + i * 8192, R, C); const int Rb = Epi::PERM ? ((R & ~31) + perm32(R & 31)) : R;
        voffA[i] = (unsigned)(R * g.lda + C) * 2u; voffB[i] = (unsigned)(Rb * K + C) * 2u; }
    const size_t kstep = (size_t)(BK * 2);
    const size_t hstepA = (size_t)HALF * g.lda * 2, hstepB = (size_t)HALF * K * 2;
    const size_t tstepA = 2 * hstepA, tstepB = 2 * hstepB, pnA = (size_t)g.a_pn * 2;
    const unsigned ldsw = (unsigned)wid * 1024u;
    const int aoff = lds_byte(wr * 64 + fr, fq * 8), boff = lds_byte(wc * 32 + fr, fq * 8);
#define PG8_SA(b, h) (((b) * 2 + (h)) * HTB)
#define PG8_SB(b, h) ((4 + (b) * 2 + (h)) * HTB)
#define PG8_STAGE(bufoff, gbase, voff) do { _Pragma("unroll") for (int _i = 0; _i < 2; ++_i) \
        __builtin_amdgcn_global_load_lds((const unsigned*)((const char*)(gbase) + (voff)[_i]), (PG8_LAS unsigned*)(lds + (bufoff) + ldsw + _i * 8192), 16, 0, 0); } while (0)
#define PG8_LDA(dst, b, h) do { _Pragma("unroll") for (int m = 0; m < 4; ++m) _Pragma("unroll") for (int k = 0; k < 2; ++k) dst[m][k] = *(const PG8_LAS bf16x8*)(lds + PG8_SA(b, h) + aoff + m * 2048 + k * 1024); } while (0)
#define PG8_LDB(dst, b, h) do { _Pragma("unroll") for (int n = 0; n < 2; ++n) _Pragma("unroll") for (int k = 0; k < 2; ++k) dst[n][k] = *(const PG8_LAS bf16x8*)(lds + PG8_SB(b, h) + boff + n * 2048 + k * 1024); } while (0)
#define PG8_MMA(ai, bj, At, Bt) do { __builtin_amdgcn_s_setprio(1); _Pragma("unroll") for (int m = 0; m < 4; ++m) _Pragma("unroll") for (int n = 0; n < 2; ++n) _Pragma("unroll") for (int k = 0; k < 2; ++k) \
        acc[ai][bj][m][n] = __builtin_amdgcn_mfma_f32_16x16x32_bf16(Bt[n][k], At[m][k], acc[ai][bj][m][n], 0, 0, 0); __builtin_amdgcn_s_setprio(0); } while (0)
#define PG8_WAIT_V(n) asm volatile("s_waitcnt vmcnt(" #n ")" ::: "memory")
#define PG8_WAIT_L(n) asm volatile("s_waitcnt lgkmcnt(" #n ")" ::: "memory")
#define PG8_BAR __builtin_amdgcn_s_barrier()
#define PG8_SCHED __builtin_amdgcn_sched_barrier(0)
    Unit cur, nxt; int ui = 0;
    if (!S.next(0, cur)) return;
    f32x4 acc[2][2][4][2];
#pragma unroll
    for (int a = 0; a < 2; ++a)
#pragma unroll
        for (int b = 0; b < 2; ++b)
#pragma unroll
            for (int m = 0; m < 4; ++m)
#pragma unroll
                for (int n = 0; n < 2; ++n) acc[a][b][m][n] = (f32x4){0.f, 0.f, 0.f, 0.f};
    bf16x8 At[4][2], B0[2][2], B1[2][2];
    const char* cA = (const char*)g.A + (size_t)cur.pm * tstepA + (size_t)cur.pn * pnA; const char* cB = (const char*)g.Bt + (size_t)cur.pn * tstepB;
    S.a_ready(cur);
    if constexpr (SP2) {
        PG8_STAGE(PG8_SB(0, 0), cB, voffB); PG8_STAGE(PG8_SB(0, 1), cB + hstepB, voffB); PG8_STAGE(PG8_SA(0, 0), cA, voffA); PG8_STAGE(PG8_SA(0, 1), cA + hstepA, voffA);
        if (wr == 1) PG8_BAR;
        PG8_WAIT_V(2); PG8_BAR;
        PG8_STAGE(PG8_SB(1, 0), cB + kstep, voffB); PG8_STAGE(PG8_SA(1, 0), cA + kstep, voffA); PG8_STAGE(PG8_SB(1, 1), cB + hstepB + kstep, voffB);
        PG8_WAIT_V(6); PG8_BAR;
    } else {
        PG8_STAGE(PG8_SB(0, 0), cB, voffB); PG8_STAGE(PG8_SA(0, 0), cA, voffA); PG8_STAGE(PG8_SB(0, 1), cB + hstepB, voffB); PG8_STAGE(PG8_SA(0, 1), cA + hstepA, voffA);
        if (wr == 1) PG8_BAR;
        PG8_WAIT_V(4); PG8_BAR;
        PG8_STAGE(PG8_SB(1, 0), cB + kstep, voffB); PG8_STAGE(PG8_SA(1, 0), cA + kstep, voffA); PG8_STAGE(PG8_SB(1, 1), cB + hstepB + kstep, voffB);
        PG8_WAIT_V(6); PG8_BAR;
    }
    for (;;) {
        const bool has_next = S.next(ui + 1, nxt);
        const char* nA = has_next ? (const char*)g.A + (size_t)nxt.pm * tstepA + (size_t)nxt.pn * pnA : cA; const char* nB = has_next ? (const char*)g.Bt + (size_t)nxt.pn * tstepB : cB;
        for (int t = 0; t < nt; t += 2) {
            const bool last = (t == nt - 2);
            const char* a1 = cA + (size_t)(t + 1) * kstep;
            const char* a2 = last ? nA : cA + (size_t)(t + 2) * kstep; const char* b2 = last ? nB : cB + (size_t)(t + 2) * kstep;
            const char* a3 = a2 + kstep; const char* b3 = b2 + kstep;
            if (last && has_next) S.a_ready(nxt);
            if constexpr (SP2) {
            PG8_LDB(B0, 0, 0); PG8_LDB(B1, 0, 1); PG8_SCHED; PG8_LDA(At, 0, 0); PG8_STAGE(PG8_SA(1, 1), a1 + hstepA, voffA);
            PG8_WAIT_V(8); PG8_WAIT_L(0); PG8_BAR; PG8_MMA(0, 0, At, B0); PG8_MMA(0, 1, At, B1); PG8_BAR; PG8_SCHED;
            PG8_LDA(At, 0, 1); PG8_STAGE(PG8_SB(0, 0), b2, voffB); PG8_STAGE(PG8_SB(0, 1), b2 + hstepB, voffB); PG8_STAGE(PG8_SA(0, 0), a2, voffA);
            PG8_WAIT_V(8); PG8_WAIT_L(0); PG8_BAR; PG8_MMA(1, 0, At, B0); PG8_MMA(1, 1, At, B1); PG8_BAR; PG8_SCHED;
            PG8_LDB(B0, 1, 0); PG8_LDB(B1, 1, 1); PG8_SCHED; PG8_LDA(At, 1, 0); PG8_STAGE(PG8_SA(0, 1), a2 + hstepA, voffA);
            PG8_WAIT_V(8); PG8_WAIT_L(0); PG8_BAR; PG8_MMA(0, 0, At, B0); PG8_MMA(0, 1, At, B1); PG8_BAR; PG8_SCHED;
            PG8_LDA(At, 1, 1); PG8_STAGE(PG8_SB(1, 0), b3, voffB); PG8_STAGE(PG8_SB(1, 1), b3 + hstepB, voffB); PG8_STAGE(PG8_SA(1, 0), a3, voffA);
            PG8_WAIT_V(8); PG8_WAIT_L(0); PG8_BAR; PG8_MMA(1, 0, At, B0); PG8_MMA(1, 1, At, B1); PG8_BAR; PG8_SCHED;
            } else {
            PG8_LDB(B0, 0, 0); PG8_SCHED; PG8_LDA(At, 0, 0); PG8_STAGE(PG8_SA(1, 1), a1 + hstepA, voffA);
            PG8_WAIT_L(8); PG8_BAR; PG8_WAIT_L(0); PG8_MMA(0, 0, At, B0); PG8_BAR; PG8_SCHED;
            PG8_LDB(B1, 0, 1); PG8_STAGE(PG8_SB(0, 0), b2, voffB);
            PG8_BAR; PG8_WAIT_L(0); PG8_MMA(0, 1, At, B1); PG8_BAR;
            PG8_LDA(At, 0, 1); PG8_STAGE(PG8_SA(0, 0), a2, voffA);
            PG8_BAR; PG8_WAIT_L(0); PG8_MMA(1, 0, At, B0); PG8_BAR; PG8_SCHED;
            PG8_STAGE(PG8_SB(0, 1), b2 + hstepB, voffB);
            PG8_WAIT_V(6); PG8_BAR; PG8_MMA(1, 1, At, B1); PG8_BAR;
            PG8_LDB(B0, 1, 0); PG8_SCHED; PG8_LDA(At, 1, 0); PG8_STAGE(PG8_SA(0, 1), a2 + hstepA, voffA);
            PG8_WAIT_L(8); PG8_BAR; PG8_WAIT_L(0); PG8_MMA(0, 0, At, B0); PG8_BAR; PG8_SCHED;
            PG8_LDB(B1, 1, 1); PG8_STAGE(PG8_SB(1, 0), b3, voffB);
            PG8_BAR; PG8_WAIT_L(0); PG8_MMA(0, 1, At, B1); PG8_BAR;
            PG8_LDA(At, 1, 1); PG8_STAGE(PG8_SA(1, 0), a3, voffA);
            PG8_BAR; PG8_WAIT_L(0); PG8_MMA(1, 0, At, B0); PG8_BAR; PG8_SCHED;
            PG8_STAGE(PG8_SB(1, 1), b3 + hstepB, voffB);
            PG8_WAIT_V(6); PG8_BAR; PG8_MMA(1, 1, At, B1); PG8_BAR;
            }
        }
        if constexpr (ALIGN_EPI) { if (wr == 0) PG8_BAR; }
        if constexpr (!Epi::AFTER_DRAIN) { E(acc, cur, wr, wc, fr, fq); S.done(cur); }
        if (!has_next) break;
#pragma unroll
        for (int a = 0; a < 2; ++a)
#pragma unroll
            for (int b = 0; b < 2; ++b)
#pragma unroll
                for (int m = 0; m < 4; ++m)
#pragma unroll
                    for (int n = 0; n < 2; ++n) acc[a][b][m][n] = (f32x4){0.f, 0.f, 0.f, 0.f};
        cur = nxt; cA = nA; cB = nB; ++ui;
        if constexpr (ALIGN_EPI) { if (wr == 1) PG8_BAR; }
    }
    PG8_WAIT_V(0);
    if constexpr (!ALIGN_EPI) { if (wr == 0) PG8_BAR; }
    PG8_BAR;
    if constexpr (Epi::AFTER_DRAIN) { E.fused(acc, cur, wr, wc, fr, fq, lds, wid, lane); S.done(cur); }
#undef PG8_SA
#undef PG8_SB
#undef PG8_STAGE
#undef PG8_LDA
#undef PG8_LDB
#undef PG8_MMA
#undef PG8_WAIT_V
#undef PG8_WAIT_L
#undef PG8_BAR
#undef PG8_SCHED
}
}
#define GAS __attribute__((address_space(1)))
#define LAS __attribute__((address_space(3)))
typedef unsigned short bf16;
typedef unsigned v4u __attribute__((ext_vector_type(4)));
typedef float f32x4 __attribute__((ext_vector_type(4)));
typedef short bf16x8 __attribute__((ext_vector_type(8)));
typedef GAS unsigned gu32;
typedef GAS unsigned long long gu64;
#define RLX_AGENT __ATOMIC_RELAXED, __HIP_MEMORY_SCOPE_AGENT
#define LDS_WAIT() asm volatile("s_waitcnt lgkmcnt(0)" ::: "memory")
#define VM_WAIT() asm volatile("s_waitcnt vmcnt(0)" ::: "memory")
__device__ __forceinline__ unsigned long long rt() { return __builtin_amdgcn_s_memrealtime(); }
__device__ __forceinline__ unsigned f2bf(float f) { unsigned u = __builtin_bit_cast(unsigned, f); return (u + 0x7fffu + ((u >> 16) & 1u)) >> 16; }
__device__ __forceinline__ unsigned pk2(float lo, float hi) { return f2bf(lo) | (f2bf(hi) << 16); }

#define XB_TMO      128
#define XB_XCNT(j)  (256  + 64 * (j))
#define XB_XSUB(j)  (1280 + 64 * (j))
#define XB_XGEN(j)  (2304 + 64 * (j))
#define XB_TOP      3328
#define XB_TOPGEN   3392
#define XCD_BAR_WORDS 3456
#define XB_SPIN_CAP (1u << 18)

__device__ __forceinline__ unsigned xb_ld(unsigned* p)              { return __hip_atomic_load(p, __ATOMIC_RELAXED, __HIP_MEMORY_SCOPE_AGENT); }
__device__ __forceinline__ unsigned xb_add(unsigned* p, unsigned v) { return __hip_atomic_fetch_add(p, v, __ATOMIC_RELAXED, __HIP_MEMORY_SCOPE_AGENT); }
__device__ __forceinline__ unsigned xb_xcc_id() { return (unsigned)__builtin_amdgcn_s_getreg((3 << 11) | 20) & 0xFu; }
#define XB_SPIN(cond, bar) do { unsigned _sp = 0; while (cond) { __builtin_amdgcn_s_sleep(1); \
    if ((++_sp & 255u) == 0u) { if (xb_ld(&(bar)[XB_TMO])) break; if (_sp > XB_SPIN_CAP) { atomicAdd(&(bar)[XB_TMO], 1u); break; } } } } while (0)

struct XcdBarrier {
    unsigned* bar; unsigned x;
    volatile LAS unsigned* st;
};

__device__ __forceinline__ XcdBarrier xcd_barrier_post(unsigned* bar, volatile LAS unsigned* st) {
    XcdBarrier b; b.bar = bar; b.x = xb_xcc_id(); b.st = st;
    if (threadIdx.x == 0) (void)xb_add(&bar[XB_XCNT(b.x)], 1u);
    return b;
}
__device__ __forceinline__ void xcd_barrier_complete(unsigned* bar, unsigned x, unsigned& nloc, unsigned& nx) {
    const unsigned G = gridDim.x * gridDim.y * gridDim.z;
    unsigned sum, cnt, mine, sp = 0u;
    for (;;) {
        sum = 0u; cnt = 0u; mine = 0u;
#pragma unroll
        for (unsigned j = 0; j < 16; ++j) { const unsigned c = xb_ld(&bar[XB_XCNT(j)]); sum += c; cnt += (c > 0u) ? 1u : 0u; mine = (j == x) ? c : mine; }
        if (sum == G) break;
        __builtin_amdgcn_s_sleep(1);
        if ((++sp & 255u) == 0u) { if (xb_ld(&bar[XB_TMO])) break; if (sp > XB_SPIN_CAP) { atomicAdd(&bar[XB_TMO], 1u); break; } }
    }
    nloc = mine > 0u ? mine : 1u; nx = cnt > 0u ? cnt : 1u;
}

__device__ __forceinline__ void xcd_barrier(const XcdBarrier& b) {
    asm volatile("s_waitcnt vmcnt(0)" ::: "memory");
    __syncthreads();
    if (threadIdx.x == 0) {
        unsigned* bar = b.bar;
        __builtin_amdgcn_s_waitcnt(0);
        unsigned nloc = b.st[0], nx = b.st[1];
        if (nloc == 0u) { xcd_barrier_complete(bar, b.x, nloc, nx); b.st[0] = nloc; b.st[1] = nx; }
        const unsigned old = xb_add(&bar[XB_XSUB(b.x)], 1u);
        const unsigned gen = old / nloc;
        if (old + 1u == (gen + 1u) * nloc) {
            __builtin_amdgcn_fence(__ATOMIC_RELEASE, "");
            asm volatile("s_waitcnt vmcnt(0)" ::: "memory");
            const unsigned og = xb_add(&bar[XB_TOP], 1u);
            const unsigned tg = og / nx;
            if (og + 1u == (tg + 1u) * nx) xb_add(&bar[XB_TOPGEN], 1u);
            else XB_SPIN(xb_ld(&bar[XB_TOPGEN]) == tg, bar);
            __builtin_amdgcn_fence(__ATOMIC_ACQUIRE, "");
            xb_add(&bar[XB_XGEN(b.x)], 1u);
            asm volatile("s_waitcnt vmcnt(0)" ::: "memory");
        } else {
            XB_SPIN(xb_ld(&bar[XB_XGEN(b.x)]) == gen, bar);
            __builtin_amdgcn_fence(__ATOMIC_ACQUIRE, "");
            asm volatile("s_waitcnt vmcnt(0)" ::: "memory");
        }
    }
    __syncthreads();
}
#include <hip/hip_bf16.h>
#include <cmath>
namespace attn_body {
using bf16=__hip_bfloat16;
using bf16x8=__attribute__((ext_vector_type(8)))short;
using s16x4=__attribute__((ext_vector_type(4)))short;
using f32x16=__attribute__((ext_vector_type(16)))float;
using u32x4=__attribute__((ext_vector_type(4)))unsigned;
constexpr int BATCH=16,NVH=32,SEQ=2048,D=64,DM=1024;
constexpr int NW=8,QBLK=32,QB=QBLK*NW,KVBLK=64,NQB=SEQ/QB;
constexpr int ATTN_PITCH=DM, ATTN_UNIT_ROWS=QB;
__device__ __forceinline__ int crow(int r,int hi){return (r&3)+8*(r>>2)+4*hi;}
#define SBAR() __builtin_amdgcn_sched_barrier(0)
constexpr int BT_N=640;
typedef __attribute__((address_space(3))) const float* lds_fptr;
__device__ __forceinline__ void cmask(f32x16&p0,f32x16&p1,int jb,int qrel,int hi,lds_fptr tb){
  const lds_fptr base=tb+(qrel-64*jb-4*hi+256-59);
  asm volatile("s_waitcnt lgkmcnt(0)\n\ts_nop 7\n\ts_nop 7":"+v"(p0),"+v"(p1)::"memory"); SBAR();
  { float f[16];
    #pragma unroll
    for(int r=0;r<16;++r){const int c=(r&3)+8*(r>>2); f[r]=base[59-c];}
    asm volatile("s_waitcnt lgkmcnt(0)\n\ts_nop 7":"+v"(p0)::"memory"); SBAR();
    #pragma unroll
    for(int r=0;r<16;++r)p0[r]+=f[r];
    asm volatile("s_nop 3":"+v"(p0)::"memory"); SBAR(); }
  { float f[16];
    #pragma unroll
    for(int r=0;r<16;++r){const int c=(r&3)+8*(r>>2); f[r]=base[59-c-32];}
    asm volatile("s_waitcnt lgkmcnt(0)\n\ts_nop 7":"+v"(p1)::"memory"); SBAR();
    #pragma unroll
    for(int r=0;r<16;++r)p1[r]+=f[r];
    asm volatile("s_nop 3":"+v"(p1)::"memory"); SBAR(); }
}

constexpr int NSLOT=3, SLOTB=8192;
constexpr int LDS_K=0, LDS_V=2*NSLOT*SLOTB, LDS_WS=LDS_V+2*NSLOT*SLOTB, LDS_TAB=LDS_WS+NW*64*4, LDS_BYTES=LDS_TAB+640*4;
constexpr float C2=0.125f*1.4426950408889634f;
__device__ __forceinline__ void glds16(const void*gsrc,unsigned lds_dst){unsigned keep;
  asm volatile("s_mov_b32 %0, m0\n\ts_mov_b32 m0, %2\n\ts_nop 0\n\tglobal_load_lds_dwordx4 %1, off\n\ts_mov_b32 m0, %0":"=&s"(keep):"v"(gsrc),"s"(lds_dst):"memory");}
__device__ __forceinline__ float max3f(float a,float b,float c){float r;asm("v_max3_f32 %0, %1, %2, %3":"=v"(r):"v"(a),"v"(b),"v"(c));return r;}
__device__ __forceinline__ float max2f(float a,float b){float r;asm("v_max_f32_e32 %0, %1, %2":"=v"(r):"v"(a),"v"(b));return r;}
__device__ __forceinline__ float fadd_s(float a,float b){float r;asm("v_add_f32_e32 %0, %1, %2":"=v"(r):"v"(a),"v"(b));return r;}
__device__ __forceinline__ float fsub_s(float a,float b){float r;asm("v_sub_f32_e32 %0, %1, %2":"=v"(r):"v"(a),"v"(b));return r;}
typedef float f32x2_t __attribute__((ext_vector_type(2))); typedef __bf16 bf16x2_t __attribute__((ext_vector_type(2)));
__device__ __forceinline__ unsigned cvtpk_s(float lo,float hi){f32x2_t v={lo,hi};bf16x2_t b=__builtin_convertvector(v,bf16x2_t);return __builtin_bit_cast(unsigned,b);}
#define WAIT_BAR(N) asm volatile("s_waitcnt vmcnt(" #N ") lgkmcnt(0)\n\ts_barrier":::"memory")

__device__ __forceinline__ void qkt(f32x16&p0,f32x16&p1,const char*Kslot,const bf16x8*qr,const f32x16&negm,int r32,int hi){
  const char*kb=Kslot+hi*1024+r32*16;
  #pragma unroll
  for(int d0=0;d0<4;++d0){
    const bf16x8 b0=*reinterpret_cast<const bf16x8*>(kb+d0*2048);
    const bf16x8 b1=*reinterpret_cast<const bf16x8*>(kb+d0*2048+512);
    if(d0==0){p0=__builtin_amdgcn_mfma_f32_32x32x16_bf16(b0,qr[0],negm,0,0,0);p1=__builtin_amdgcn_mfma_f32_32x32x16_bf16(b1,qr[0],negm,0,0,0);}
    else{p0=__builtin_amdgcn_mfma_f32_32x32x16_bf16(b0,qr[d0],p0,0,0,0);p1=__builtin_amdgcn_mfma_f32_32x32x16_bf16(b1,qr[d0],p1,0,0,0);}}
}
typedef __attribute__((address_space(3))) const char* lds_cptr;
typedef short v4i16_t __attribute__((ext_vector_type(4)));
__device__ __forceinline__ void kload8(bf16x8*kf,lds_cptr kp){
  kf[0]=*(const __attribute__((address_space(3))) bf16x8*)(kp);      kf[1]=*(const __attribute__((address_space(3))) bf16x8*)(kp+512);
  kf[2]=*(const __attribute__((address_space(3))) bf16x8*)(kp+2048); kf[3]=*(const __attribute__((address_space(3))) bf16x8*)(kp+2560);
  kf[4]=*(const __attribute__((address_space(3))) bf16x8*)(kp+4096); kf[5]=*(const __attribute__((address_space(3))) bf16x8*)(kp+4608);
  kf[6]=*(const __attribute__((address_space(3))) bf16x8*)(kp+6144); kf[7]=*(const __attribute__((address_space(3))) bf16x8*)(kp+6656);
}
__device__ __forceinline__ void kload2(bf16x8*kf,lds_cptr kp,int j){ kf[2*j]=*(const __attribute__((address_space(3))) bf16x8*)(kp+j*2048); kf[2*j+1]=*(const __attribute__((address_space(3))) bf16x8*)(kp+j*2048+512); }
__device__ __forceinline__ s16x4 vtr(lds_cptr p){ return __builtin_bit_cast(s16x4,__builtin_amdgcn_ds_read_tr16_b64_v4i16((__attribute__((address_space(3))) v4i16_t*)p)); }
__device__ __forceinline__ float rowmax(const f32x16&p0,const f32x16&p1){
  float a=max3f(p0[0],p0[1],p1[0]),b=max3f(p0[2],p0[3],p1[1]);a=max3f(a,p1[2],p1[3]);
  #pragma unroll
  for(int r=4;r<16;r+=4){a=max3f(a,p0[r],p0[r+1]);b=max3f(b,p0[r+2],p0[r+3]);a=max3f(a,p1[r],p1[r+1]);b=max3f(b,p1[r+2],p1[r+3]);}
  const float m=max2f(a,b);
  auto rr=__builtin_amdgcn_permlane32_swap(__float_as_uint(m),__float_as_uint(m),false,false);
  return max2f(__uint_as_float(rr[0]),__uint_as_float(rr[1]));
}
#ifndef ATTN_STORE16
#define ATTN_STORE16(p,v) (*(u32x4*)(p)=(v))
#endif
template<int THRL> __device__ __forceinline__ void attn_unit(int b,int h,int qb,const bf16*Q,const bf16*__restrict__ K,const bf16*__restrict__ V,const bf16*__restrict__ GA,bf16*MGo,char*shm,lds_fptr tb,float lam,const float*subw){
  int tid=threadIdx.x; asm volatile("":"+v"(tid)); const int lane=tid&63,r32=lane&31,hi=lane>>5; const int wid=__builtin_amdgcn_readfirstlane(tid>>6), grp=wid>>2, w4=wid&3;
  const long rowbase=(long)b*SEQ; const int q0=qb*128, qcol=h*128+grp*64, vcol=h*128;
  const bf16*Qw=Q+(rowbase+q0+w4*QBLK)*DM+qcol;
  const bf16*Kh=K+rowbase*DM+qcol,*Vh=V+rowbase*DM+vcol;
  const unsigned lds0=(unsigned)(uintptr_t)shm;
  float*wsf=(float*)(shm+LDS_WS)+wid*64;
  const bf16*ksrc=Kh+(long)lane*DM+w4*16;
  const bf16*vsrc=Vh+(long)(16*(wid&3)+(lane>>2))*DM+(wid>>2)*32+(lane&3)*8;
  const unsigned kdst=lds0+LDS_K+grp*(NSLOT*SLOTB)+w4*2048, vdst=lds0+LDS_V+wid*1024;
  #define DMA_K1(t,ks) do{ glds16(ksrc+(long)(t)*KVBLK*DM,(unsigned)__builtin_amdgcn_readfirstlane(kdst+(ks))); glds16(ksrc+(long)(t)*KVBLK*DM+8,(unsigned)__builtin_amdgcn_readfirstlane(kdst+(ks)+1024)); }while(0)
  #define DMA_V2(t,vs) do{ glds16(vsrc+(long)(t)*KVBLK*DM,(unsigned)__builtin_amdgcn_readfirstlane(vdst+(vs))); glds16(vsrc+(long)(t)*KVBLK*DM+64,(unsigned)__builtin_amdgcn_readfirstlane(vdst+(vs)+8192)); }while(0)
  const lds_cptr shm3=(lds_cptr)shm; const lds_cptr vp0=shm3+LDS_V+((lane>>4)&1)*32+(lane&3)*8+(4*hi+((lane&15)>>2))*64;
  const lds_cptr kp0=shm3+LDS_K+grp*(NSLOT*SLOTB)+hi*1024+r32*16;
  const int NT=(q0+128)/KVBLK;
  asm volatile("s_waitcnt vmcnt(0)":::"memory");
  DMA_K1(0,0); DMA_K1(1,SLOTB); DMA_V2(0,0); if(NT>2)DMA_K1(2,2*SLOTB); DMA_V2(1,2*SLOTB);
  bf16x8 qr[4];
  #pragma unroll
  for(int d0=0;d0<4;++d0)qr[d0]=*reinterpret_cast<const bf16x8*>(&Qw[(long)r32*DM+d0*16+hi*8]);
  asm volatile("s_waitcnt vmcnt(0) lgkmcnt(0)\n\ts_barrier":::"memory");
  float mhat=0.f,l_reg=0.f; f32x16 o[4]; o[0]=f32x16{};o[1]=f32x16{};o[2]=f32x16{};o[3]=f32x16{}; f32x16 negm=f32x16{};
  const int qrel=w4*QBLK+r32;
  bool resc=false;
  #define MX3(a,b,c) __builtin_fmaxf(__builtin_fmaxf((a),(b)),(c))
  #define EX(v) __builtin_amdgcn_exp2f(v)
  #define KFR(off) (*(const __attribute__((address_space(3))) bf16x8*)(kp_+(off)))
  #define QKT(P0,P1) do{ P0=__builtin_amdgcn_mfma_f32_32x32x16_bf16(KFR(0),qr[0],negm,0,0,0); P1=__builtin_amdgcn_mfma_f32_32x32x16_bf16(KFR(512),qr[0],negm,0,0,0); \
      P0=__builtin_amdgcn_mfma_f32_32x32x16_bf16(KFR(2048),qr[1],P0,0,0,0); P1=__builtin_amdgcn_mfma_f32_32x32x16_bf16(KFR(2560),qr[1],P1,0,0,0); \
      P0=__builtin_amdgcn_mfma_f32_32x32x16_bf16(KFR(4096),qr[2],P0,0,0,0); P1=__builtin_amdgcn_mfma_f32_32x32x16_bf16(KFR(4608),qr[2],P1,0,0,0); \
      P0=__builtin_amdgcn_mfma_f32_32x32x16_bf16(KFR(6144),qr[3],P0,0,0,0); P1=__builtin_amdgcn_mfma_f32_32x32x16_bf16(KFR(6656),qr[3],P1,0,0,0); }while(0)
  #define DECIDE(P0,P1,RM) do{ resc=false; if(__builtin_expect(__any((RM)>(float)THRL),0)){ const float dl=__builtin_fmaxf((RM),0.f); mhat+=dl; \
        _Pragma("unroll") for(int r=0;r<16;++r){P0[r]-=dl;P1[r]-=dl;} \
        _Pragma("unroll") for(int r=0;r<16;++r)negm[r]=-mhat; \
        const float f=__builtin_amdgcn_exp2f(-dl); l_reg*=f; if(hi==0)wsf[r32]=f; resc=true; } }while(0)
  #define RESC() do{ if(resc){ asm volatile("s_waitcnt lgkmcnt(0)":::"memory"); \
      _Pragma("unroll") for(int d_=0;d_<4;++d_) _Pragma("unroll") for(int r=0;r<16;++r)o[d_][r]*=wsf[crow(r,hi)]; asm volatile("s_waitcnt lgkmcnt(0)":::"memory"); } }while(0)
  #define ROWMAX(P0,P1,RM) do{ float a_=MX3(P0[0],P0[1],P1[0]),b_=MX3(P0[2],P0[3],P1[1]); a_=MX3(a_,P1[2],P1[3]); \
      _Pragma("unroll") for(int r=4;r<16;r+=4){a_=MX3(a_,P0[r],P0[r+1]);b_=MX3(b_,P0[r+2],P0[r+3]);a_=MX3(a_,P1[r],P1[r+1]);b_=MX3(b_,P1[r+2],P1[r+3]);} \
      RM=__builtin_fmaxf(a_,b_); { auto rr=__builtin_amdgcn_permlane32_swap(__float_as_uint(RM),__float_as_uint(RM),false,false); RM=__builtin_fmaxf(__uint_as_float(rr[0]),__uint_as_float(rr[1])); } }while(0)
  #define PACK(P0,P1) do{ pw0=(u32x4){cvtpk_s(P0[0],P0[1]),cvtpk_s(P0[2],P0[3]),cvtpk_s(P0[4],P0[5]),cvtpk_s(P0[6],P0[7])}; pw1=(u32x4){cvtpk_s(P0[8],P0[9]),cvtpk_s(P0[10],P0[11]),cvtpk_s(P0[12],P0[13]),cvtpk_s(P0[14],P0[15])}; \
      pw2=(u32x4){cvtpk_s(P1[0],P1[1]),cvtpk_s(P1[2],P1[3]),cvtpk_s(P1[4],P1[5]),cvtpk_s(P1[6],P1[7])}; pw3=(u32x4){cvtpk_s(P1[8],P1[9]),cvtpk_s(P1[10],P1[11]),cvtpk_s(P1[12],P1[13]),cvtpk_s(P1[14],P1[15])}; }while(0)
  u32x4 pw[4];
  #define pw0 pw[0]
  #define pw1 pw[1]
  #define pw2 pw[2]
  #define pw3 pw[3]
  { const lds_cptr kp_=kp0; f32x16 p0,p1; QKT(p0,p1);
    { const int jb=0-(NT-2); if(jb>=-2)cmask(p0,p1,jb,qrel,hi,tb); }
    float rm; ROWMAX(p0,p1,rm); DECIDE(p0,p1,rm); RESC();
    float sacc=0.f;
    #pragma unroll
    for(int r=0;r<16;++r){p0[r]=EX(p0[r]);p1[r]=EX(p1[r]);sacc+=p0[r]+p1[r];}
    l_reg+=sacc; PACK(p0,p1); }
  int kn=SLOTB,vs=0;
  #define VFRAG(q_,s_) ({ const s16x4 lo_=vtr(vp_+(q_)*4096+(s_)*1024), hi_=vtr(vp_+(q_)*4096+(s_)*1024+512); (bf16x8){lo_[0],lo_[1],lo_[2],lo_[3],hi_[0],hi_[1],hi_[2],hi_[3]}; })
  #define PIN(x) asm volatile("":"+v"(x))
  #define PAW(k) __builtin_bit_cast(bf16x8,pw[k])
  #define FQA(i) ((i)<8?((i)&1):2+((i)&1))
  #define FSA(i) (((i)&7)>>1)
  #define FQB(i) ((i)&3)
  #define FSB(i) ((i)>>2)
  #define GAP3(i,FQ,FS,FILL) do{ if((i)+2<16) vf[((i)+2)%3]=VFRAG(FQ((i)+2),FS((i)+2)); o[FQ(i)]=__builtin_amdgcn_mfma_f32_32x32x16_bf16(PAW(FS(i)),vf[(i)%3],o[FQ(i)],0,0,0); FILL; SBAR(); }while(0)
  for(int t=0;t<NT;++t){
    if(t==0) asm volatile("s_waitcnt lgkmcnt(0)\n\ts_barrier":::"memory");
    else{ if(t+2<NT) asm volatile("s_waitcnt vmcnt(4) lgkmcnt(0)\n\ts_barrier":::"memory"); else if(t+1<NT) asm volatile("s_waitcnt vmcnt(2) lgkmcnt(0)\n\ts_barrier":::"memory"); else asm volatile("s_waitcnt vmcnt(0) lgkmcnt(0)\n\ts_barrier":::"memory"); }
    if(t+3<NT) DMA_K1(t+3,((t+3)%3)*SLOTB);
    if(t+2<NT) DMA_V2(t+2,((t+2)%3)*2*SLOTB);
    const lds_cptr vp_=vp0+vs;
    bf16x8 vf[3];
    if(t+1<NT){
      const lds_cptr kp_=kp0+kn; f32x16 p0,p1;
      bf16x8 kf[8]; SBAR();
      kf[0]=KFR(0);kf[1]=KFR(512);kf[2]=KFR(2048);kf[3]=KFR(2560);kf[4]=KFR(4096);kf[5]=KFR(4608);kf[6]=KFR(6144);kf[7]=KFR(6656); vf[0]=VFRAG(FQA(0),FSA(0)); vf[1]=VFRAG(FQA(1),FSA(1)); SBAR();
      p0=__builtin_amdgcn_mfma_f32_32x32x16_bf16(kf[0],qr[0],negm,0,0,0); p1=__builtin_amdgcn_mfma_f32_32x32x16_bf16(kf[1],qr[0],negm,0,0,0);
      p0=__builtin_amdgcn_mfma_f32_32x32x16_bf16(kf[2],qr[1],p0,0,0,0);   p1=__builtin_amdgcn_mfma_f32_32x32x16_bf16(kf[3],qr[1],p1,0,0,0);
      p0=__builtin_amdgcn_mfma_f32_32x32x16_bf16(kf[4],qr[2],p0,0,0,0);   p1=__builtin_amdgcn_mfma_f32_32x32x16_bf16(kf[5],qr[2],p1,0,0,0);
      p0=__builtin_amdgcn_mfma_f32_32x32x16_bf16(kf[6],qr[3],p0,0,0,0);   p1=__builtin_amdgcn_mfma_f32_32x32x16_bf16(kf[7],qr[3],p1,0,0,0); SBAR();
      GAP3(0,FQA,FSA,);  GAP3(1,FQA,FSA,);  GAP3(2,FQA,FSA,);  GAP3(3,FQA,FSA,);
      { const int jb=t+1-(NT-2); if(jb>=-2)cmask(p0,p1,jb,qrel,hi,tb); }
      float ma,mb,rm;
      GAP3(4,FQA,FSA, ma=MX3(p0[0],p0[1],p1[0]); mb=MX3(p0[2],p0[3],p1[1]); ma=MX3(ma,p1[2],p1[3]); PIN(ma); PIN(mb));
      GAP3(5,FQA,FSA, ma=MX3(ma,p0[4],p0[5]); mb=MX3(mb,p0[6],p0[7]); ma=MX3(ma,p1[4],p1[5]); mb=MX3(mb,p1[6],p1[7]); PIN(ma); PIN(mb));
      GAP3(6,FQA,FSA, ma=MX3(ma,p0[8],p0[9]); mb=MX3(mb,p0[10],p0[11]); ma=MX3(ma,p1[8],p1[9]); mb=MX3(mb,p1[10],p1[11]); PIN(ma); PIN(mb));
      GAP3(7,FQA,FSA, ma=MX3(ma,p0[12],p0[13]); mb=MX3(mb,p0[14],p0[15]); ma=MX3(ma,p1[12],p1[13]); mb=MX3(mb,p1[14],p1[15]); rm=__builtin_fmaxf(ma,mb); PIN(rm));
      { auto rr=__builtin_amdgcn_permlane32_swap(__float_as_uint(rm),__float_as_uint(rm),false,false); rm=__builtin_fmaxf(__uint_as_float(rr[0]),__uint_as_float(rr[1])); }
      DECIDE(p0,p1,rm);
      float sacc=0.f; u32x4 pn0,pn1,pn2,pn3; SBAR();
      #define FILLX(X,B,PN,I) X[B]=EX(X[B]); X[B+1]=EX(X[B+1]); X[B+2]=EX(X[B+2]); X[B+3]=EX(X[B+3]); sacc+=(X[B]+X[B+1])+(X[B+2]+X[B+3]); PN[I]=cvtpk_s(X[B],X[B+1]); PN[I+1]=cvtpk_s(X[B+2],X[B+3]); PIN(PN); PIN(sacc)
      GAP3(8,FQA,FSA, FILLX(p0,0,pn0,0));  GAP3(9,FQA,FSA, FILLX(p0,4,pn0,2));  GAP3(10,FQA,FSA, FILLX(p0,8,pn1,0));  GAP3(11,FQA,FSA, FILLX(p0,12,pn1,2));
      GAP3(12,FQA,FSA, FILLX(p1,0,pn2,0));  GAP3(13,FQA,FSA, FILLX(p1,4,pn2,2));  GAP3(14,FQA,FSA, FILLX(p1,8,pn3,0));  GAP3(15,FQA,FSA, FILLX(p1,12,pn3,2));
      #undef FILLX
      l_reg+=sacc; RESC(); pw0=pn0; pw1=pn1; pw2=pn2; pw3=pn3;
    } else {
      vf[0]=VFRAG(FQB(0),FSB(0)); vf[1]=VFRAG(FQB(1),FSB(1)); SBAR();
      GAP3(0,FQB,FSB,);  GAP3(1,FQB,FSB,);  GAP3(2,FQB,FSB,);  GAP3(3,FQB,FSB,);  GAP3(4,FQB,FSB,);  GAP3(5,FQB,FSB,);  GAP3(6,FQB,FSB,);  GAP3(7,FQB,FSB,);
      GAP3(8,FQB,FSB,);  GAP3(9,FQB,FSB,);  GAP3(10,FQB,FSB,);  GAP3(11,FQB,FSB,);  GAP3(12,FQB,FSB,);  GAP3(13,FQB,FSB,);  GAP3(14,FQB,FSB,);  GAP3(15,FQB,FSB,);
    }
    kn=(kn==2*SLOTB)?0:kn+SLOTB; vs=(vs==4*SLOTB)?0:vs+2*SLOTB;
  }
  #undef GAP3
  #undef FQA
  #undef FSA
  #undef FQB
  #undef FSB
  #undef pw0
  #undef pw1
  #undef pw2
  #undef pw3
  #undef PIN
  #undef PAW
  #undef VFRAG
  #undef PVM
  {auto rr=__builtin_amdgcn_permlane32_swap(__float_as_uint(l_reg),__float_as_uint(l_reg),false,false);l_reg=__uint_as_float(rr[0])+__uint_as_float(rr[1]);}
  if(hi==0)wsf[32+r32]=l_reg;asm volatile("s_waitcnt lgkmcnt(0)":::"memory");
  float rli[16];
  #pragma unroll
  for(int r=0;r<16;++r)rli[r]=__builtin_amdgcn_rcpf(wsf[32+crow(r,hi)]);
  asm volatile("s_waitcnt lgkmcnt(0)\n\ts_barrier":::"memory");
  { bf16*stg=(bf16*)shm+wid*4096;
    #pragma unroll
    for(int r=0;r<16;++r){const int orow=crow(r,hi);
      #pragma unroll
      for(int d0=0;d0<4;++d0)stg[orow*128+d0*32+r32]=__float2bfloat16(o[d0][r]*rli[r]);} }
  asm volatile("s_waitcnt lgkmcnt(0)\n\ts_barrier":::"memory");
  { const int row=16*grp+(lane>>2), c32=(lane&3)*32;
    const bf16*sa=(const bf16*)shm+w4*4096+row*128+c32, *sb=(const bf16*)shm+(4+w4)*4096+row*128+c32;
    const size_t go=(size_t)(rowbase+q0+w4*QBLK+row)*DM+vcol+c32;
    float d[32]; float ss=0.f;
    #pragma unroll
    for(int i=0;i<4;++i){ const u32x4 a1=*(const u32x4*)(sa+8*i), a2=*(const u32x4*)(sb+8*i);
      #pragma unroll
      for(int j=0;j<4;++j){ const unsigned x1=a1[j], x2=a2[j]; const float dl=__uint_as_float(x1<<16)-lam*__uint_as_float(x2<<16), dh=__uint_as_float(x1&0xffff0000u)-lam*__uint_as_float(x2&0xffff0000u);
        d[8*i+2*j]=dl; d[8*i+2*j+1]=dh; ss+=dl*dl+dh*dh; } }
    ss+=__shfl_xor(ss,1); ss+=__shfl_xor(ss,2);
    const float rr_=__builtin_amdgcn_rsqf(ss*(1.0f/128.0f)+1e-5f)*0.8f;
    #pragma unroll
    for(int i=0;i<4;++i){ const u32x4 ga=*(const u32x4*)(GA+go+8*i); const f32x4 s0=*(const f32x4*)(subw+c32+8*i), s1=*(const f32x4*)(subw+c32+8*i+4); u32x4 w;
      #pragma unroll
      for(int j=0;j<4;++j){ const unsigned g=ga[j]; const float gl=__uint_as_float(g<<16), gh=__uint_as_float(g&0xffff0000u);
        const float sl=(j<2)?s0[2*j]:s1[2*j-4], sh=(j<2)?s0[2*j+1]:s1[2*j-3];
        const float ol=__builtin_amdgcn_rcpf(1.0f+__builtin_amdgcn_exp2f(-1.4426950408889634f*gl))*d[8*i+2*j]*rr_*sl, oh=__builtin_amdgcn_rcpf(1.0f+__builtin_amdgcn_exp2f(-1.4426950408889634f*gh))*d[8*i+2*j+1]*rr_*sh;
        w[j]=cvtpk_s(ol,oh); }
      ATTN_STORE16(MGo+go+8*i,w); } }
  asm volatile("s_waitcnt lgkmcnt(0)\n\ts_barrier":::"memory");
  #undef DMA_K1
  #undef DMA_V2
  #undef MX3
  #undef EX
  #undef KFR
  #undef QKT
  #undef DECIDE
  #undef RESC
  #undef ROWMAX
  #undef PACK
}
constexpr int ATTN_LDS_BYTES=LDS_BYTES;
struct AttnTensors { const bf16* Q; const bf16* K; const bf16* V; const bf16* GA; bf16* MG; };
template<int THRL=8> __device__ __forceinline__ void attn_phase(char*lds,const AttnTensors&T,int vcu,lds_fptr tball,float lam,const float*subw){
  const int b=vcu>>4, h=(vcu>>1)&7, half=vcu&1;
  for(int i=0;i<8;++i){ const int pr=i>>1, qb=4*pr+(half?((i&1)?2:1):((i&1)?3:0));
    attn_unit<THRL>(b,h,qb,T.Q,T.K,T.V,T.GA,T.MG,lds,tball,lam,subw); }
}
#undef SBAR
#undef WAIT_BAR
}

constexpr int NWAVES = 8;
constexpr int BATCH = 16, SEQ = 2048, D = 1024, M = BATCH * SEQ, DIN = 6144, DQ2 = 2048, NSEL = 128;
constexpr float C2 = 0.125f * 1.4426950408889634f;
constexpr float LOG2E = 1.4426950408889634f;
constexpr size_t MiB = 1u << 20;
constexpr size_t WS_CTL = 0, CTL_ZERO_BYTES = 1 * MiB;
constexpr size_t WS_MOD = 128 * 1024;
constexpr size_t WS_WIN = 1 * MiB, WS_WOUT = 13 * MiB, WS_WQ = 15 * MiB, WS_WPOOL = 19 * MiB, WS_KEYS = 19 * MiB + 512 * 1024;
constexpr size_t WS_EXP8 = 20 * MiB;
constexpr size_t WS_SCALES = 36 * MiB;
constexpr size_t WS_MODF = 36 * MiB + 256 * 1024;
constexpr size_t WS_XN = 52 * MiB;
constexpr size_t WS_Q = 116 * MiB, WS_K = 180 * MiB, WS_V = 244 * MiB, WS_P = 308 * MiB, WS_GA = 372 * MiB, WS_GP = 436 * MiB, WS_END = 500 * MiB;
constexpr size_t WS_MG = WS_Q;
constexpr size_t WS_SELI = WS_P, WS_SELG = WS_P + 16 * MiB, WS_SELD = WS_P + 32 * MiB;
constexpr size_t WS_Q2 = WS_K;
constexpr int CW_BAR = 4096;
constexpr int RING_BYTES = 131072, LDSCTL_OFF = 153600, MISC_OFF = LDSCTL_OFF + 320, LDS_BYTES = 155648;

struct Frame {
    LAS unsigned char* lds; volatile LAS unsigned* MISC; gu32* ctl;
    int tid, lane, wave, vcu, G;
    const float* in[22]; float* out; unsigned char* ws;
};
__device__ __forceinline__ void refresh(Frame& F) { int t = threadIdx.x; asm volatile("" : "+v"(t)); F.tid = t; F.lane = t & 63; }
typedef int i32x4 __attribute__((ext_vector_type(4)));
__device__ __forceinline__ f32x4 ldmod4(const int* p) { const i32x4 v = *(const i32x4*)p; return (f32x4){(float)v.x, (float)v.y, (float)v.z, (float)v.w} * (1.0f / 16777216.0f); }
__device__ __forceinline__ float wave_sum(float v) {
#pragma unroll
    for (int o = 1; o < 64; o <<= 1) v += __shfl_xor(v, o);
    return v;
}
__device__ __forceinline__ float bflo(unsigned w) { return __builtin_bit_cast(float, w << 16); }
__device__ __forceinline__ float bfhi(unsigned w) { return __builtin_bit_cast(float, w & 0xffff0000u); }
__device__ __forceinline__ float sigm(float x) { return 1.0f / (1.0f + __expf(-x)); }

__device__ __forceinline__ void p0_transpose_item(const float* W, int K, int N, bf16* WT, int row_off, LAS float* scr, int item, int lane, const float* colscale = nullptr) {
    const int nblk = N / 32, kb = item / nblk, nb = item % nblk, k0 = 64 * kb, n0 = 32 * nb;
    const float cs = colscale ? colscale[n0 + (lane & 31)] : 1.0f;
#pragma unroll 8
    for (int i = 0; i < 32; ++i) { const int kk = 2 * i + (lane >> 5); scr[kk * 33 + (lane & 31)] = W[(size_t)(k0 + kk) * N + n0 + (lane & 31)] * cs; }
    LDS_WAIT(); asm volatile("" ::: "memory");
    const int c = lane & 7;
#pragma unroll
    for (int j = 0; j < 4; ++j) { const int n = (lane >> 3) + 8 * j; const LAS float* s = scr + (8 * c) * 33 + n;
        v4u o; o.x = pk2(s[0 * 33], s[1 * 33]); o.y = pk2(s[2 * 33], s[3 * 33]); o.z = pk2(s[4 * 33], s[5 * 33]); o.w = pk2(s[6 * 33], s[7 * 33]);
        *(GAS v4u*)(WT + (size_t)(row_off + n0 + n) * K + k0 + 8 * c) = o; }
    LDS_WAIT(); asm volatile("" ::: "memory");
}
__device__ __forceinline__ void p0_mod_item(Frame& F, int id, LAS float* scr) {
    const int cb = id % 96, kc = id / 96, n = cb * 64 + F.lane;
    const float* c = F.in[1]; const float* wada = F.in[2]; const float* bada = F.in[3];
#pragma unroll 4
    for (int i = 0; i < 32; ++i) { const int e = i * 64 + F.lane, b = e >> 7, k = e & 127; const float cv = c[b * D + kc * 128 + k]; scr[k * 16 + b] = cv / (1.0f + __expf(-cv)); }
    LDS_WAIT(); asm volatile("" ::: "memory");
    float acc[16];
#pragma unroll
    for (int b = 0; b < 16; ++b) acc[b] = 0.f;
#pragma unroll 4
    for (int k = 0; k < 128; ++k) {
        const float w = wada[(size_t)(kc * 128 + k) * DIN + n];
        const f32x4 c0 = *(const LAS f32x4*)(scr + k * 16), c1 = *(const LAS f32x4*)(scr + k * 16 + 4), c2 = *(const LAS f32x4*)(scr + k * 16 + 8), c3 = *(const LAS f32x4*)(scr + k * 16 + 12);
        acc[0] += c0.x * w; acc[1] += c0.y * w; acc[2] += c0.z * w; acc[3] += c0.w * w; acc[4] += c1.x * w; acc[5] += c1.y * w; acc[6] += c1.z * w; acc[7] += c1.w * w;
        acc[8] += c2.x * w; acc[9] += c2.y * w; acc[10] += c2.z * w; acc[11] += c2.w * w; acc[12] += c3.x * w; acc[13] += c3.y * w; acc[14] += c3.z * w; acc[15] += c3.w * w;
    }
    int* mod = (int*)(F.ws + WS_MOD);
    const float bb = (kc == 0) ? bada[n] : 0.f;
#pragma unroll
    for (int b = 0; b < 16; ++b) atomicAdd(mod + b * DIN + n, (int)rintf((acc[b] + bb) * 16777216.0f));
    LDS_WAIT(); asm volatile("" ::: "memory");
}
__device__ __forceinline__ void p0_quant_expert(Frame& F, int e) {
    const int lane = F.lane;
    const GAS f32x4* sd = (const GAS f32x4*)(F.in[19] + (size_t)e * D) + 4 * lane;
    const GAS f32x4* su = (const GAS f32x4*)(F.in[20] + (size_t)e * D) + 4 * lane;
    f32x4 vd[4], vu[4]; float ssd = 0.f, ssu = 0.f;
#pragma unroll
    for (int j = 0; j < 4; ++j) { vd[j] = sd[j]; vu[j] = su[j]; }
#pragma unroll
    for (int j = 0; j < 4; ++j) { ssd += (vd[j].x * vd[j].x + vd[j].y * vd[j].y) + (vd[j].z * vd[j].z + vd[j].w * vd[j].w); ssu += (vu[j].x * vu[j].x + vu[j].y * vu[j].y) + (vu[j].z * vu[j].z + vu[j].w * vu[j].w); }
#pragma unroll
    for (int o = 1; o < 64; o <<= 1) { ssd += __shfl_xor(ssd, o); ssu += __shfl_xor(ssu, o); }
    const float stepd = fmaxf(0.3352f * sqrtf(ssd * (1.f / D)), 1e-30f), stepu = fmaxf(0.48f * sqrtf(ssu * (1.f / D)), 1e-30f), invd = 1.0f / stepd, invu = 1.0f / stepu;
    v4u w;
#pragma unroll
    for (int k = 0; k < 2; ++k) { unsigned ad = 0u, au = 0u;
#pragma unroll
        for (int j = 0; j < 8; ++j) {
            { const float x = vd[2 * k + (j >> 2)][j & 3] * invd; int u = (int)floorf(x) + 8; u = u < 0 ? 0 : (u > 15 ? 15 : u); ad |= ((unsigned)u ^ 8u) << (4 * j); }
            { const float x = vu[2 * k + (j >> 2)][j & 3] * invu, a = fabsf(x);
              unsigned code = (a < 0.25f) ? 0u : (a < 0.75f) ? 1u : (a < 1.25f) ? 2u : (a < 1.75f) ? 3u : (a < 2.5f) ? 4u : (a < 3.5f) ? 5u : (a < 5.0f) ? 6u : 7u; if (x < 0.f) code |= 8u; au |= code << (4 * j); } }
        if (k == 0) { w.x = ad; w.z = au; } else { w.y = ad; w.w = au; } }
    *(GAS v4u*)(F.ws + WS_EXP8 + (size_t)e * 1024 + 16 * lane) = w;
    if (lane == 0) { ((float*)(F.ws + WS_SCALES))[2 * e] = stepd; ((float*)(F.ws + WS_SCALES))[2 * e + 1] = stepu; }
}
__device__ __forceinline__ void p0a_prologue(Frame& F) {
    LAS float* scr = (LAS float*)(F.lds + F.wave * 16384);
    const int gw = F.vcu * NWAVES + F.wave, NGW = F.G * NWAVES;
    constexpr int I_MOD = 768, I_IN = (D / 64) * (DIN / 32), I_OUT = (D / 64) * (D / 32), I_WQ = (D / 64) * (DQ2 / 32), I_PW = (256 / 64) * (256 / 32), I_KEYS = 2 * 131072 / 512;
    constexpr int I_EXP = 16384;
    constexpr int NITEMS = I_MOD + I_IN + I_OUT + I_WQ + 4 * I_PW + I_KEYS + I_EXP;
    constexpr int NLIGHT = NITEMS - I_MOD, NH = I_MOD, LH = 5 * NH;
    const bool heavy = F.wave < 3 && F.G * 3 == NH;
    const int hidx = F.vcu * 3 + F.wave, lidx = heavy ? 0 : (F.G * 3 == NH ? F.vcu * 5 + (F.wave - 3) : gw), nl = (F.G * 3 == NH) ? F.G * 5 : NGW;
    if (heavy) p0_mod_item(F, hidx, scr);
    if (F.G * 3 != NH) { for (int it = gw; it < I_MOD; it += NGW) p0_mod_item(F, it, scr); }
    const int first = heavy ? hidx : ((F.G * 3 == NH) ? LH + lidx : gw), step = heavy ? NH : nl, lim = heavy ? LH : NLIGHT;
    for (int it = first; it < lim; it += step) {
        int r = it;
        if (r < I_IN) { p0_transpose_item(F.in[5], D, DIN, (bf16*)(F.ws + WS_WIN), 0, scr, r, F.lane); continue; } r -= I_IN;
        if (r < I_OUT) { p0_transpose_item(F.in[14], D, D, (bf16*)(F.ws + WS_WOUT), 0, scr, r, F.lane); continue; } r -= I_OUT;
        if (r < I_WQ) { p0_transpose_item(F.in[16], D, DQ2, (bf16*)(F.ws + WS_WQ), 0, scr, r, F.lane); continue; } r -= I_WQ;
        if (r < 4 * I_PW) { const int g = r / I_PW; p0_transpose_item(F.in[12] + (size_t)g * 65536, 256, 256, (bf16*)(F.ws + WS_WPOOL) + (size_t)g * 65536, 0, scr, r % I_PW, F.lane, F.in[13] + g * 256); continue; } r -= 4 * I_PW;
        if (r >= I_KEYS) { p0_quant_expert(F, r - I_KEYS); continue; }
        { const int e0 = r * 512 + F.lane * 8; const float* src = (e0 < 131072) ? (F.in[17] + e0) : (F.in[18] + (e0 - 131072));
          const f32x4 a = *(const f32x4*)src, b = *(const f32x4*)(src + 4);
          v4u o; o.x = pk2(a[0], a[1]); o.y = pk2(a[2], a[3]); o.z = pk2(b[0], b[1]); o.w = pk2(b[2], b[3]);
          const int hh = e0 >> 14, key = (e0 >> 7) & 127, d0 = e0 & 127;
          *(GAS v4u*)((bf16*)(F.ws + WS_KEYS) + (((hh * 4 + (key >> 5)) * 8 + (d0 >> 4)) * 512 + (((d0 >> 3) & 1) * 32 + (key & 31)) * 8)) = o; }
    }
}
__device__ __forceinline__ f32x4 ld4bf(const bf16* p) { const unsigned long long w = *(const unsigned long long*)p; const unsigned lo = (unsigned)w, hi = (unsigned)(w >> 32); return (f32x4){bflo(lo), bfhi(lo), bflo(hi), bfhi(hi)}; }
template <bool SRC_BF16> __device__ __forceinline__ void norm_mod_rows_t(Frame& F, const void* srcv, const float* nw, int sh_off, int sc_off, bf16* dst, float eps) {
    const int gw = F.vcu * NWAVES + F.wave, NGW = F.G * NWAVES;
    const float* mod = (const float*)(F.ws + WS_MODF);
    for (int m0 = gw; m0 < M; m0 += 2 * NGW) {
        const int m1 = m0 + NGW;
        f32x4 v0[4], v1[4]; float s0 = 0.f, s1 = 0.f;
#pragma unroll
        for (int j = 0; j < 4; ++j) {
            if (SRC_BF16) { v0[j] = ld4bf((const bf16*)srcv + (size_t)m0 * D + 4 * F.lane + 256 * j); v1[j] = ld4bf((const bf16*)srcv + (size_t)m1 * D + 4 * F.lane + 256 * j); }
            else { v0[j] = *((const GAS f32x4*)((const float*)srcv + (size_t)m0 * D) + F.lane + 64 * j); v1[j] = *((const GAS f32x4*)((const float*)srcv + (size_t)m1 * D) + F.lane + 64 * j); } }
#pragma unroll
        for (int j = 0; j < 4; ++j) { s0 += (v0[j].x * v0[j].x + v0[j].y * v0[j].y) + (v0[j].z * v0[j].z + v0[j].w * v0[j].w); s1 += (v1[j].x * v1[j].x + v1[j].y * v1[j].y) + (v1[j].z * v1[j].z + v1[j].w * v1[j].w); }
#pragma unroll
        for (int o = 1; o < 64; o <<= 1) { s0 += __shfl_xor(s0, o); s1 += __shfl_xor(s1, o); }
        const float r0 = 1.0f / sqrtf(s0 * (1.f / D) + eps), r1 = 1.0f / sqrtf(s1 * (1.f / D) + eps);
        const int b0 = m0 >> 11, b1 = m1 >> 11;
        GAS unsigned long long* o0 = (GAS unsigned long long*)(dst + (size_t)m0 * D) + F.lane; GAS unsigned long long* o1 = (GAS unsigned long long*)(dst + (size_t)m1 * D) + F.lane;
#pragma unroll
        for (int j = 0; j < 4; ++j) { const int col = 4 * F.lane + 256 * j; const f32x4 w = *(const f32x4*)(nw + col);
            { const f32x4 sc = *(const f32x4*)(mod + b0 * DIN + sc_off + col), sh = *(const f32x4*)(mod + b0 * DIN + sh_off + col); const f32x4 hq = v0[j] * r0 * w * (sc + 1.0f) + sh;
              o0[64 * j] = (unsigned long long)pk2(hq.x, hq.y) | ((unsigned long long)pk2(hq.z, hq.w) << 32); }
            { const f32x4 sc = *(const f32x4*)(mod + b1 * DIN + sc_off + col), sh = *(const f32x4*)(mod + b1 * DIN + sh_off + col); const f32x4 hq = v1[j] * r1 * w * (sc + 1.0f) + sh;
              o1[64 * j] = (unsigned long long)pk2(hq.x, hq.y) | ((unsigned long long)pk2(hq.z, hq.w) << 32); } }
    }
}
__device__ __forceinline__ void p0b_rows(Frame& F, bf16* dst) {
    LAS float* ms = (LAS float*)F.lds;
    const int b = F.vcu >> 4; int* mi = (int*)(F.ws + WS_MOD) + b * DIN; float* mf = (float*)(F.ws + WS_MODF) + b * DIN;
    for (int i = F.tid; i < 2048; i += NWAVES * 64) ms[i] = (float)__hip_atomic_fetch_add(mi + i, 0, __ATOMIC_RELAXED, __HIP_MEMORY_SCOPE_AGENT) * (1.0f / 16777216.0f);
    { const int seg = (F.vcu & 15) * 384; if (F.tid < 384) mf[seg + F.tid] = (float)__hip_atomic_fetch_add(mi + seg + F.tid, 0, __ATOMIC_RELAXED, __HIP_MEMORY_SCOPE_AGENT) * (1.0f / 16777216.0f); }
    __syncthreads();
    const float* src = F.in[0]; const float* nw = F.in[4];
#pragma unroll 1
    for (int k = 0; k < 16; k += 2) {
        const int m0 = F.vcu * 128 + F.wave + 8 * k, m1 = m0 + 8;
        f32x4 v0[4], v1[4]; float s0 = 0.f, s1 = 0.f;
#pragma unroll
        for (int j = 0; j < 4; ++j) { v0[j] = *((const GAS f32x4*)(src + (size_t)m0 * D) + F.lane + 64 * j); v1[j] = *((const GAS f32x4*)(src + (size_t)m1 * D) + F.lane + 64 * j); }
#pragma unroll
        for (int j = 0; j < 4; ++j) { s0 += (v0[j].x * v0[j].x + v0[j].y * v0[j].y) + (v0[j].z * v0[j].z + v0[j].w * v0[j].w); s1 += (v1[j].x * v1[j].x + v1[j].y * v1[j].y) + (v1[j].z * v1[j].z + v1[j].w * v1[j].w); }
#pragma unroll
        for (int o = 1; o < 64; o <<= 1) { s0 += __shfl_xor(s0, o); s1 += __shfl_xor(s1, o); }
        const float r0 = 1.0f / sqrtf(s0 * (1.f / D) + 1e-6f), r1 = 1.0f / sqrtf(s1 * (1.f / D) + 1e-6f);
        GAS unsigned long long* o0 = (GAS unsigned long long*)(dst + (size_t)m0 * D) + F.lane; GAS unsigned long long* o1 = (GAS unsigned long long*)(dst + (size_t)m1 * D) + F.lane;
#pragma unroll
        for (int j = 0; j < 4; ++j) { const int col = 4 * F.lane + 256 * j; const f32x4 w = *(const f32x4*)(nw + col);
            const f32x4 sh = *(const LAS f32x4*)(ms + col), sc = *(const LAS f32x4*)(ms + 1024 + col);
            { const f32x4 hq = v0[j] * r0 * w * (sc + 1.0f) + sh; o0[64 * j] = (unsigned long long)pk2(hq.x, hq.y) | ((unsigned long long)pk2(hq.z, hq.w) << 32); }
            { const f32x4 hq = v1[j] * r1 * w * (sc + 1.0f) + sh; o1[64 * j] = (unsigned long long)pk2(hq.x, hq.y) | ((unsigned long long)pk2(hq.z, hq.w) << 32); } }
    }
}
__device__ __forceinline__ void fill_bias_table2(Frame& F, LAS float* tb, int h) {
    const float* rb = F.in[11];
    for (int i = F.tid; i < 640; i += NWAVES * 64) { const int dist = i - 256;
        float v;
        if (dist < 0) v = -INFINITY; else if (dist >= 128) v = 0.f;
        else { int bk = dist; if (dist >= 16) { bk = 16 + (int)(log2f((float)dist * (1.f / 16.f)) * (16.f / 3.f)); if (bk > 31) bk = 31; } v = (rb[bk * 8 + h] - rb[31 * 8 + h]) * LOG2E; }
        tb[i] = v; }
}
template <int W> __device__ __forceinline__ void pool_item(const bf16* __restrict__ P, bf16* __restrict__ PO, int b, int chunk, int g, int lane) {
    const int t0 = chunk * 64, col = g * 256 + lane * 4; const size_t rowb = (size_t)b * SEQ;
    f32x4 ring[16], nw[16];
#pragma unroll
    for (int i = 0; i < 16; ++i) { const int t = t0 - 16 + i; ring[i] = (t >= 0) ? ld4bf(P + (rowb + t) * D + col) : (f32x4){0.f, 0.f, 0.f, 0.f}; }
    for (int blk = 0; blk < 4; ++blk) {
#pragma unroll
        for (int i = 0; i < 16; ++i) nw[i] = ld4bf(P + (rowb + t0 + blk * 16 + i) * D + col);
#pragma unroll
        for (int i = 0; i < 16; ++i) { const int t = t0 + blk * 16 + i;
            f32x4 s = nw[i];
#pragma unroll
            for (int j = 1; j < W; ++j) s += (i - j >= 0) ? nw[i - j] : ring[16 + i - j];
            const int cnt = (t + 1 < W) ? (t + 1) : W;
            const f32x4 r = s * (1.0f / (float)cnt) - nw[i];
            *(unsigned long long*)(PO + (rowb + t) * D + col) = (unsigned long long)pk2(r.x, r.y) | ((unsigned long long)pk2(r.z, r.w) << 32); }
#pragma unroll
        for (int i = 0; i < 16; ++i) ring[i] = nw[i];
    }
}
typedef short rbf16x8 __attribute__((ext_vector_type(8)));
typedef float rf32x16 __attribute__((ext_vector_type(16)));
__device__ __forceinline__ void ce_desc(float& a, float& b) { const float hi = __builtin_fmaxf(a, b), lo = __builtin_fminf(a, b); a = hi; b = lo; }
__device__ __forceinline__ void bitonic_merge16_desc(float (&v)[16]) {
#pragma unroll
    for (int j = 8; j > 0; j >>= 1)
#pragma unroll
        for (int i = 0; i < 16; ++i) { const int l = i ^ j; if (l > i) ce_desc(v[i], v[l]); }
}
__device__ __forceinline__ void sort16_desc(float (&v)[16]) {
#pragma unroll
    for (int k = 2; k <= 16; k <<= 1)
#pragma unroll
        for (int j = k >> 1; j > 0; j >>= 1)
#pragma unroll
            for (int i = 0; i < 16; ++i) { const int l = i ^ j; if (l > i) { if ((i & k) == 0) ce_desc(v[i], v[l]); else ce_desc(v[l], v[i]); } }
}
__device__ __forceinline__ void merge_top16(float (&a)[16], const float (&b)[16]) {
#pragma unroll
    for (int i = 0; i < 16; ++i) a[i] = __builtin_fmaxf(a[i], b[15 - i]);
    bitonic_merge16_desc(a);
}
__device__ __forceinline__ float pack_idx(float s, unsigned keepmask, unsigned idx) { return __builtin_bit_cast(float, (__builtin_bit_cast(unsigned, s) & keepmask) | idx); }
__device__ __forceinline__ void fold_block(const rf32x16& acc, int blk, int hi, float (&top)[16]) {
    if (blk == 0) {
#pragma unroll
        for (int r = 0; r < 16; ++r) top[r] = pack_idx(acc[r], 0xFFFFFF80u, (unsigned)((r & 3) + 8 * (r >> 2)) + 4u * (unsigned)hi);
        sort16_desc(top);
    } else {
        float g[16];
#pragma unroll
        for (int r = 0; r < 16; ++r) g[r] = pack_idx(acc[r], 0xFFFFFF80u, (unsigned)(32 * blk + (r & 3) + 8 * (r >> 2)) + 4u * (unsigned)hi);
        sort16_desc(g); merge_top16(top, g);
    }
}
__device__ __forceinline__ void merge_pair(float (&top)[16], int hi) {
    float o[16];
#pragma unroll
    for (int i = 0; i < 16; ++i) { const unsigned u = __builtin_bit_cast(unsigned, top[i]); auto rr = __builtin_amdgcn_permlane32_swap(u, u, false, false); o[i] = __builtin_bit_cast(float, hi ? rr[0] : rr[1]); }
    merge_top16(top, o);
}
typedef float f32x2g __attribute__((ext_vector_type(2)));
__host__ __device__ constexpr int cand_pos(int i, int j) { int p = 0; for (int a = 0; a < 16; ++a) for (int b = 0; b < 16; ++b) { if (a == i && b == j) return p; if ((a + 1) * (b + 1) <= 16) ++p; } return p; }
static_assert(cand_pos(15, 0) == 49, "50 candidate pairs");
__device__ __forceinline__ void retrieval_mfma(Frame& F, const bf16* Q2, const bf16* KEYS, int* SELI, float* SELG, int tt0, int tt1) {
    const int h = F.wave;
    const __amdgpu_buffer_rsrc_t rq = __builtin_amdgcn_make_buffer_rsrc((void*)Q2, (short)0, M * DQ2 * 2, 0x00020000);
    const __amdgpu_buffer_rsrc_t rk = __builtin_amdgcn_make_buffer_rsrc((void*)KEYS, (short)0, 2 * 8 * 128 * 128 * 2, 0x00020000);
#pragma unroll 1
    for (int tt = tt0; tt < tt1; ++tt) {
        const int T0 = F.vcu * 128 + tt * 32;
        int lane = F.lane; asm volatile("" : "+v"(lane));
        const int r32 = lane & 31, hi = lane >> 5;
        float v1[16], v2[16];
#pragma unroll
        for (int half = 0; half < 2; ++half) {
            const int qoff = (((T0 >> 5) * 8 + h) * 2 + half) * 8192 + lane * 16;
            const int koff = lane * 16, ksoff = (half * 8 + h) * 128 * 128 * 2;
            rbf16x8 bq[8];
#pragma unroll
            for (int ks = 0; ks < 8; ++ks) bq[ks] = __builtin_bit_cast(rbf16x8, __builtin_amdgcn_raw_buffer_load_b128(rq, qoff + ks * 1024, 0, 0));
            rbf16x8 ak[2][8];
#pragma unroll
            for (int ks = 0; ks < 8; ++ks) ak[0][ks] = __builtin_bit_cast(rbf16x8, __builtin_amdgcn_raw_buffer_load_b128(rk, koff + ks * 1024, ksoff, 0));
#pragma unroll
            for (int blk = 0; blk < 4; ++blk) {
                if (blk < 3) {
#pragma unroll
                    for (int ks = 0; ks < 8; ++ks) ak[(blk + 1) & 1][ks] = __builtin_bit_cast(rbf16x8, __builtin_amdgcn_raw_buffer_load_b128(rk, koff + (blk + 1) * 8192 + ks * 1024, ksoff, 0));
                }
                rf32x16 acc = (rf32x16){0.f, 0.f, 0.f, 0.f, 0.f, 0.f, 0.f, 0.f, 0.f, 0.f, 0.f, 0.f, 0.f, 0.f, 0.f, 0.f};
#pragma unroll
                for (int ks = 0; ks < 8; ++ks) acc = __builtin_amdgcn_mfma_f32_32x32x16_bf16(ak[blk & 1][ks], bq[ks], acc, 0, 0, 0);
                if (half == 0) fold_block(acc, blk, hi, v1); else fold_block(acc, blk, hi, v2);
                asm volatile("" ::: "memory");
            }
            if (half == 0) merge_pair(v1, hi); else merge_pair(v2, hi);
        }
        float c0[16], c1[16], c2[16], c3[16];
#pragma unroll
        for (int i = 0; i < 16; ++i)
#pragma unroll
            for (int j = 0; j < 16; ++j) if ((i + 1) * (j + 1) <= 16) {
                const int p = cand_pos(i, j);
                const unsigned e = ((__builtin_bit_cast(unsigned, v1[i]) & 0x7Fu) << 7) | (__builtin_bit_cast(unsigned, v2[j]) & 0x7Fu);
                const float sv = pack_idx(v1[i] + v2[j], 0xFFFFC000u, e);
                if (p < 16) c0[p & 15] = sv; else if (p < 32) c1[p & 15] = sv; else if (p < 48) c2[p & 15] = sv; else c3[p & 15] = sv; }
#pragma unroll
        for (int q = 2; q < 16; ++q) c3[q] = -INFINITY;
        sort16_desc(c0); sort16_desc(c1); sort16_desc(c2); sort16_desc(c3);
        merge_top16(c0, c1); merge_top16(c2, c3); merge_top16(c0, c2);
        float ev[16]; float sum = 0.f;
#pragma unroll
        for (int k = 0; k < 16; ++k) { ev[k] = __expf(c0[k] - c0[0]); sum += ev[k]; }
        const float inv = 1.0f / sum;
        const size_t o = (size_t)(T0 + r32) * NSEL + h * 16;
        const float* SC = (const float*)(F.ws + WS_SCALES); float* SELD = (float*)(F.ws + WS_SELD);
        { unsigned e8[8]; float g8[8];
#pragma unroll
          for (int k = 0; k < 8; ++k) { e8[k] = __builtin_bit_cast(unsigned, hi ? c0[8 + k] : c0[k]) & 0x3FFFu; g8[k] = (hi ? ev[8 + k] : ev[k]) * inv; }
          f32x2g sc[8];
#pragma unroll
          for (int k = 0; k < 8; ++k) sc[k] = *(const f32x2g*)(SC + 2 * e8[k]);
          const size_t o8 = o + 8 * hi;
          *(v4u*)(SELI + o8) = (v4u){e8[0], e8[1], e8[2], e8[3]}; *(v4u*)(SELI + o8 + 4) = (v4u){e8[4], e8[5], e8[6], e8[7]};
          *(f32x4*)(SELD + o8) = (f32x4){sc[0].x, sc[1].x, sc[2].x, sc[3].x}; *(f32x4*)(SELD + o8 + 4) = (f32x4){sc[4].x, sc[5].x, sc[6].x, sc[7].x};
          *(f32x4*)(SELG + o8) = (f32x4){g8[0] * sc[0].y, g8[1] * sc[1].y, g8[2] * sc[2].y, g8[3] * sc[3].y}; *(f32x4*)(SELG + o8 + 4) = (f32x4){g8[4] * sc[4].y, g8[5] * sc[5].y, g8[6] * sc[6].y, g8[7] * sc[7].y}; }
    }
}
__device__ __forceinline__ float ub0(unsigned w) { return (float)(w & 0xffu); }
__device__ __forceinline__ float ub1(unsigned w) { return (float)((w >> 8) & 0xffu); }
__device__ __forceinline__ float ub2(unsigned w) { return (float)((w >> 16) & 0xffu); }
__device__ __forceinline__ float ub3(unsigned w) { return (float)(w >> 24); }
__device__ __forceinline__ float gelu1(float v) {
    const float av = fabsf(v), t = __builtin_amdgcn_rcpf(av * 0.2316418882f + 1.0f);
    float q = t * 0.5307027145f + (-0.7265760135f); q = q * t + 0.7107068705f; q = q * t + (-0.142248368f); q = q * t + 0.127414796f; q = q * t;
    const float e = __builtin_amdgcn_exp2f((v * v) * (-0.72134752044f)), m = v * (q * e);
    return v < 0.f ? m : v - m;
}
__device__ __forceinline__ int xch32(int v, int lane) { auto rr = __builtin_amdgcn_permlane32_swap((unsigned)v, (unsigned)v, false, false); return (int)((lane & 32) ? rr[0] : rr[1]); }
__device__ __forceinline__ int xch16(int v, int lane) { auto rr = __builtin_amdgcn_permlane16_swap((unsigned)v, (unsigned)v, false, false); return (int)((lane & 16) ? rr[0] : rr[1]); }
__device__ __forceinline__ int xch8(int v) { return __builtin_amdgcn_update_dpp(0, v, 0x128, 0xf, 0xf, false); }
__device__ __forceinline__ int red8i(int v) { v += __builtin_amdgcn_update_dpp(0, v, 0x141, 0xf, 0xf, false);
    v += __builtin_amdgcn_update_dpp(0, v, 0x4E, 0xf, 0xf, false); v += __builtin_amdgcn_update_dpp(0, v, 0xB1, 0xf, 0xf, false); return v; }
typedef unsigned u32x2g __attribute__((ext_vector_type(2)));
typedef int v8i32_t __attribute__((ext_vector_type(8)));
#define PEER4_COMPUTE(c, RB, GG, DD) do { int p[8]; \
        _Pragma("unroll") for (int i = 0; i < 8; ++i) { const int w0 = (int)RB[i].x, w1 = (int)RB[i].y; int dh, dl; \
            asm("v_dot8_i32_i4 %0, %1, %2, 0" : "=v"(dh) : "v"(w0), "v"(hA0)); asm("v_dot8_i32_i4 %0, %1, %2, %0" : "+v"(dh) : "v"(w1), "v"(hA1)); \
            asm("v_dot8_i32_i4 %0, %1, %2, 0" : "=v"(dl) : "v"(w0), "v"(hB0)); asm("v_dot8_i32_i4 %0, %1, %2, %0" : "+v"(dl) : "v"(w1), "v"(hB1)); p[i] = (dh << 4) + dl; } \
          \
        int q4[4], q2[2], q1; \
        _Pragma("unroll") for (int i = 0; i < 4; ++i) { auto r_ = __builtin_amdgcn_permlane32_swap((unsigned)p[i], (unsigned)p[4 + i], false, false); q4[i] = (int)(r_[0] + r_[1]); } \
        _Pragma("unroll") for (int i = 0; i < 2; ++i) { auto r_ = __builtin_amdgcn_permlane16_swap((unsigned)q4[i], (unsigned)q4[2 + i], false, false); q2[i] = (int)(r_[0] + r_[1]); } \
        { const int keep = (lane & 8) ? q2[1] : q2[0], send = (lane & 8) ? q2[0] : q2[1]; q1 = keep + xch8(send); } \
        q1 = red8i(q1); \
        const float wv = GG * gelu1(DD * hscale * ((float)q1 - hoff));     \
        const float ws_ = __builtin_amdgcn_fmed3f(wv * 512.0f, -448.0f, 448.0f); \
        const int wq_ = __builtin_amdgcn_cvt_pk_fp8_f32(ws_, ws_, 0, false); \
        _Pragma("unroll") for (int i = 0; i < 8; i += 2) { \
            const unsigned ci = ((unsigned)__builtin_amdgcn_ds_bpermute(abp_ + 32 * i, wq_) & 0xffu) << ash;     \
            v8i32_t av_; av_[0] = am0 ? (int)ci : 0; av_[1] = am1 ? (int)ci : 0; av_[2] = am2 ? (int)ci : 0; av_[3] = am3 ? (int)ci : 0; av_[4] = am4 ? (int)ci : 0; av_[5] = am5 ? (int)ci : 0; av_[6] = am6 ? (int)ci : 0; av_[7] = am7 ? (int)ci : 0; \
            const v8i32_t bv_ = (v8i32_t){(int)RB[i].z, (int)RB[i].w, (int)RB[i + 1].z, (int)RB[i + 1].w, 0, 0, 0, 0}; \
            acc = __builtin_amdgcn_mfma_scale_f32_32x32x64_f8f6f4(av_, bv_, acc, 0  , 4  , 0, 118  , 0, 127); } } while (0)
#define PEERS_LOAD(tok, cc, EA, EB, RB, GG, DD) do { const int cc_ = (cc); const size_t so_ = (size_t)(tok) * NSEL + cc_ * 8 + isel; GG = SELG[so_]; DD = SELD[so_]; \
        const int Ec_ = (cc_ < 8) ? (EA) : (EB); const int sb_ = (cc_ & 7) * 8; \
        _Pragma("unroll") for (int i = 0; i < 8; ++i) { const int e = __builtin_amdgcn_readlane(Ec_, sb_ + i); \
        const v4u rw = __builtin_bit_cast(v4u, __builtin_amdgcn_raw_buffer_load_b128(rexp, 16 * lane, e * 1024, 0)); RB[i] = rw; } } while (0)
#define PEERS_PROLOGUE() do { float h[16]; \
        { const v4u w0 = hr0, w1 = hr1; \
          h[0] = bflo(w0.x); h[1] = bfhi(w0.x); h[2] = bflo(w0.y); h[3] = bfhi(w0.y); h[4] = bflo(w0.z); h[5] = bfhi(w0.z); h[6] = bflo(w0.w); h[7] = bfhi(w0.w); \
          h[8] = bflo(w1.x); h[9] = bfhi(w1.x); h[10] = bflo(w1.y); h[11] = bfhi(w1.y); h[12] = bflo(w1.z); h[13] = bfhi(w1.z); h[14] = bflo(w1.w); h[15] = bfhi(w1.w); } \
        float am = 0.f; \
        _Pragma("unroll") for (int i = 0; i < 16; ++i) am = fmaxf(am, fabsf(h[i])); \
        _Pragma("unroll") for (int i = 0; i < 16; ++i) acc[i] = 0.f; \
        _Pragma("unroll") for (int o = 1; o < 64; o <<= 1) am = fmaxf(am, __shfl_xor(am, o)); \
        am = fmaxf(am, 1e-30f); \
        const float hinv = 119.0f / am; hscale = am * (1.0f / 119.0f); \
          \
          \
        int hsum = 0; hA0 = 0u; hA1 = 0u; hB0 = 0u; hB1 = 0u; \
        _Pragma("unroll") for (int i = 0; i < 16; ++i) { const int hq = (int)rintf(h[i] * hinv); hsum += hq; const int bd = ((hq + 8) & 15) - 8, ad = (hq - bd) >> 4; \
            if (i < 8) { hA0 |= (unsigned)(ad & 15) << (4 * i); hB0 |= (unsigned)(bd & 15) << (4 * i); } else { hA1 |= (unsigned)(ad & 15) << (4 * (i - 8)); hB1 |= (unsigned)(bd & 15) << (4 * (i - 8)); } } \
        _Pragma("unroll") for (int o = 1; o < 64; o <<= 1) hsum += __shfl_xor(hsum, o); \
        hoff = -0.5f * (float)hsum;                   \
          \
        xr0 = *(const v4u*)(X1 + (size_t)t * D + 16 * lane); xr1 = *(const v4u*)(X1 + (size_t)t * D + 16 * lane + 8); \
        if (t + NWAVES < tend) { const int tn_ = t + NWAVES; En0 = SELI[(size_t)tn_ * NSEL + lane]; En1 = SELI[(size_t)tn_ * NSEL + 64 + lane]; \
            hr0 = *(const v4u*)(H2 + (size_t)tn_ * D + 16 * lane); hr1 = *(const v4u*)(H2 + (size_t)tn_ * D + 16 * lane + 8); } } while (0)
#define PEERS_EPILOGUE() do { float x2[16]; float ss = 0.f; \
        _Pragma("unroll") for (int j = 0; j < 4; ++j) { const int col = 16 * lane + 4 * j; const unsigned wlo = (j < 2) ? (j == 0 ? xr0.x : xr0.z) : (j == 2 ? xr1.x : xr1.z), whi = (j < 2) ? (j == 0 ? xr0.y : xr0.w) : (j == 2 ? xr1.y : xr1.w); \
            const f32x4 xv = (f32x4){bflo(wlo), bfhi(wlo), bflo(whi), bfhi(whi)}, g2 = *(const LAS f32x4*)(g2s + col); \
            x2[4 * j] = xv.x + g2.x * acc[4 * j]; x2[4 * j + 1] = xv.y + g2.y * acc[4 * j + 1]; x2[4 * j + 2] = xv.z + g2.z * acc[4 * j + 2]; x2[4 * j + 3] = xv.w + g2.w * acc[4 * j + 3]; \
            ss += (x2[4 * j] * x2[4 * j] + x2[4 * j + 1] * x2[4 * j + 1]) + (x2[4 * j + 2] * x2[4 * j + 2] + x2[4 * j + 3] * x2[4 * j + 3]); } \
        const float rr = 1.0f / sqrtf(wave_sum(ss) * (1.f / D) + 1e-6f); \
        _Pragma("unroll") for (int j = 0; j < 4; ++j) { const int col = 16 * lane + 4 * j; const f32x4 w = *(const LAS f32x4*)(nfws + col); \
            *(f32x4*)(OUT + (size_t)t * D + col) = (f32x4){x2[4 * j] * rr * w.x, x2[4 * j + 1] * rr * w.y, x2[4 * j + 2] * rr * w.z, x2[4 * j + 3] * rr * w.w}; } } while (0)
#define PEERS_SLOT(CRB, CG, CD, LRB, LG, LD) do { \
        if ((n & 15) == 0) { if (n > 0) { PEERS_EPILOGUE(); t += NWAVES; E0 = En0; E1 = En1; } PEERS_PROLOGUE(); } \
        { const int n2 = n + 2; if (n2 < total) { const bool nx = (n2 >> 4) != (n >> 4); PEERS_LOAD(nx ? t + NWAVES : t, n2 & 15, nx ? En0 : E0, nx ? En1 : E1, LRB, LG, LD); } } \
        PEER4_COMPUTE(0, CRB, CG, CD); ++n; } while (0)
__device__ __forceinline__ void peer_q4(Frame& F, const bf16* H2, const bf16* X1, const int* SELI, const float* SELG, float* OUT, int tfirst, int tend, const LAS float* g2s, const LAS float* nfws) {
    const int lane = F.lane, isel = (lane >> 3) & 7;
    const float* SELD = (const float*)(F.ws + WS_SELD);
    const __amdgpu_buffer_rsrc_t rexp = __builtin_amdgcn_make_buffer_rsrc((void*)(F.ws + WS_EXP8), (short)0, 16384 * 1024, 0x00020000);
    if (tfirst >= tend) return;
    const int total = ((tend - tfirst + NWAVES - 1) / NWAVES) * (NSEL / 8);
    int t = tfirst, n = 0;
    int E0 = SELI[(size_t)tfirst * NSEL + lane], E1 = SELI[(size_t)tfirst * NSEL + 64 + lane], En0 = 0, En1 = 0;
    v4u hr0 = *(const v4u*)(H2 + (size_t)tfirst * D + 16 * lane), hr1 = *(const v4u*)(H2 + (size_t)tfirst * D + 16 * lane + 8), xr0, xr1;
    v4u rbA[8], rbB[8], rbC[8]; float gA, sdA, gB, sdB, gC, sdC;
    rf32x16 acc;
    const int mrow_ = lane & 31, cm_ = 4 * (mrow_ >> 3) + (mrow_ & 3); const int aq_ = 4 * ((mrow_ >> 2) & 1) + (cm_ >> 2); const unsigned ash = 8u * (unsigned)(cm_ & 3);
    const int abp_ = (lane >> 5) * 32;
    const bool am0 = aq_ == 0, am1 = aq_ == 1, am2 = aq_ == 2, am3 = aq_ == 3, am4 = aq_ == 4, am5 = aq_ == 5, am6 = aq_ == 6, am7 = aq_ == 7;
    float hscale = 0.f, hoff = 0.f; unsigned hA0 = 0u, hA1 = 0u, hB0 = 0u, hB1 = 0u;
    PEERS_LOAD(tfirst, 0, E0, E1, rbA, gA, sdA); PEERS_LOAD(tfirst, 1, E0, E1, rbB, gB, sdB);
#pragma unroll 1
    while (n < total) {
        PEERS_SLOT(rbA, gA, sdA, rbC, gC, sdC);
        if (n < total) PEERS_SLOT(rbB, gB, sdB, rbA, gA, sdA);
        if (n < total) PEERS_SLOT(rbC, gC, sdC, rbB, gB, sdB);
    }
    PEERS_EPILOGUE();
}

struct Args { const float* in[22]; float* out; unsigned char* ws; };
__global__ void __launch_bounds__(NWAVES * 64, 2) fwd_megakernel(Args args) {
    extern __shared__ __attribute__((aligned(16))) unsigned char lds[];
    Frame F;
    F.lds = (LAS unsigned char*)lds; F.MISC = (volatile LAS unsigned*)(F.lds + MISC_OFF);
    F.tid = threadIdx.x; F.lane = F.tid & 63; F.wave = __builtin_amdgcn_readfirstlane(F.tid >> 6);
    F.G = gridDim.x; { const int bx = blockIdx.x; F.vcu = (F.G % 8 == 0) ? (bx % 8) * (F.G / 8) + bx / 8 : bx; }
#pragma unroll
    for (int i = 0; i < 22; ++i) F.in[i] = args.in[i];
    F.out = args.out; F.ws = args.ws; F.ctl = (gu32*)(args.ws + WS_CTL);
    for (int u = F.tid; u < (LDS_BYTES - LDSCTL_OFF) / 4; u += NWAVES * 64) ((LAS unsigned*)(F.lds + LDSCTL_OFF))[u] = 0u;
    __syncthreads();
    XcdBarrier bar = xcd_barrier_post((unsigned*)(F.ctl + CW_BAR), F.MISC + 8);
    unsigned char* ws = args.ws;
    bf16* XN = (bf16*)(ws + WS_XN); bf16* Qb = (bf16*)(ws + WS_Q); bf16* Kb = (bf16*)(ws + WS_K); bf16* Vb = (bf16*)(ws + WS_V); bf16* Pb = (bf16*)(ws + WS_P);
    bf16* GAb = (bf16*)(ws + WS_GA); bf16* GPb = (bf16*)(ws + WS_GP); bf16* MG = XN;     bf16* Q2 = (bf16*)(ws + WS_Q2);
    bf16* X1 = GAb;
    bf16* POOLED = (bf16*)F.out + (size_t)M * D;
    {
    const float* mod = (const float*)(ws + WS_MODF);
    const int gw = F.vcu * NWAVES + F.wave, NGW = F.G * NWAVES;

    refresh(F); p0a_prologue(F);
    xcd_barrier(bar);
    refresh(F); p0b_rows(F, XN);
    xcd_barrier(bar);
    refresh(F); { pg8::Gemm g{XN, (const bf16*)(ws + WS_WIN), M, DIN, D, D, 0}; pg8::StaticOrder S; S.init(M, DIN, F.G, (int)blockIdx.x);
      pg8::EpiInProj E{Qb, (size_t)(WS_K - WS_Q) / 2, C2};
      pg8::gemm_phase<pg8::EpiInProj, pg8::StaticOrder, true, true>(F.lds, g, S, E); }
    xcd_barrier(bar);
    refresh(F); {
      { LAS float* tb = (LAS float*)(F.lds + attn_body::LDS_TAB);
        fill_bias_table2(F, tb, (F.vcu >> 1) & 7);
        float lam; { const float a = F.in[6][F.lane] * F.in[7][F.lane], bq = F.in[8][F.lane] * F.in[9][F.lane]; lam = __expf(wave_sum(a)) - __expf(wave_sum(bq)) + 0.2f; }
        const attn_body::AttnTensors AT{(const attn_body::bf16*)Qb, (const attn_body::bf16*)Kb, (const attn_body::bf16*)Vb, (const attn_body::bf16*)GAb, (attn_body::bf16*)MG};
        attn_body::attn_phase<8>((char*)lds, AT, F.vcu, (attn_body::lds_fptr)tb, lam, F.in[10]); }
      for (int it = gw; it < BATCH * 32 * 4; it += NGW) { const int g = it & 3, chunk = (it >> 2) & 31, b = it >> 7;
          if (g == 0) pool_item<2>(Pb, POOLED, b, chunk, 0, F.lane); else if (g == 1) pool_item<4>(Pb, POOLED, b, chunk, 1, F.lane);
          else if (g == 2) pool_item<8>(Pb, POOLED, b, chunk, 2, F.lane); else pool_item<16>(Pb, POOLED, b, chunk, 3, F.lane); } }
    xcd_barrier(bar);
    refresh(F); { pg8::Gemm g{POOLED, (const bf16*)(ws + WS_WPOOL), M, D, 256, D, 256}; pg8::StaticOrder S; S.init(M, D, F.G, (int)blockIdx.x);
      pg8::EpiPool E{MG, GPb, D};
      pg8::gemm_phase<pg8::EpiPool, pg8::StaticOrder, true, true>(F.lds, g, S, E); }
    xcd_barrier(bar);
    refresh(F); { pg8::Gemm g{MG, (const bf16*)(ws + WS_WOUT), M, D, D, D, 0}; pg8::StaticOrder S; S.init(M, D, F.G, (int)blockIdx.x);
      pg8::EpiResidBf E{F.in[0], X1, mod + 2048, D, DIN, SEQ};
      pg8::gemm_phase<pg8::EpiResidBf, pg8::StaticOrder, true, true>(F.lds, g, S, E); }
    xcd_barrier(bar);
    refresh(F); norm_mod_rows_t<true>(F, X1, F.in[15], 3072, 4096, XN, 1e-6f);
    xcd_barrier(bar);
    refresh(F); { pg8::Gemm g{XN, (const bf16*)(ws + WS_WQ), M, DQ2, D, D, 0}; pg8::StaticOrder S; S.init(M, DQ2, F.G, (int)blockIdx.x);
      pg8::EpiQFrag E{Q2};
      pg8::gemm_phase<pg8::EpiQFrag, pg8::StaticOrder, true, true>(F.lds, g, S, E); }
    xcd_barrier(bar);
    refresh(F);
    { const bf16* KEYSb = (const bf16*)(ws + WS_KEYS); int* SELIp = (int*)(ws + WS_SELI); float* SELGp = (float*)(ws + WS_SELG);
      LAS float* g2s = (LAS float*)F.lds; LAS float* nfws = g2s + D;
      for (int i = F.tid; i < D; i += NWAVES * 64) { g2s[i] = mod[((F.vcu * 128) >> 11) * DIN + 5120 + i]; nfws[i] = F.in[21][i]; }
#pragma unroll 1
      for (int g = -1; g < 4; ++g) {
#pragma unroll 1
          for (int s = 0; s < 2; ++s) {
              if ((s == 0) == (F.wave < 4)) { if (g < 3) retrieval_mfma(F, Q2, KEYSb, SELIp, SELGp, g + 1, g + 2); }
              else if (g >= 0) peer_q4(F, XN, X1, SELIp, SELGp, F.out, F.vcu * 128 + g * 32 + F.wave, F.vcu * 128 + g * 32 + 32, g2s, nfws);
          }
          VM_WAIT(); __syncthreads();
      } }
    }
}

extern "C" void kernel_launch(void* const* d_in, const int* in_sizes, int n_in, void* d_out, int out_size, void* d_ws, size_t ws_size, hipStream_t stream) {
    static int grid = 0;
    if (grid == 0) {
        if (n_in != 22 || in_sizes[0] != M * D || out_size != M * D || ws_size < WS_END) { fprintf(stderr, "kernel_launch: unexpected shapes/workspace (n_in %d, in0 %d, out %d, ws %zu < %zu); nothing launched\n", n_in, n_in > 0 ? in_sizes[0] : -1, out_size, ws_size, (size_t)WS_END); grid = -1; return; }
        int dev = 0, cus = 0;
        if (hipGetDevice(&dev) != hipSuccess || hipDeviceGetAttribute(&cus, hipDeviceAttributeMultiprocessorCount, dev) != hipSuccess) { grid = -1; return; }
        if (hipFuncSetAttribute((const void*)fwd_megakernel, hipFuncAttributeMaxDynamicSharedMemorySize, LDS_BYTES) != hipSuccess) { fprintf(stderr, "kernel_launch: hipFuncSetAttribute failed\n"); grid = -1; return; }
        int per_cu = 0;
        if (hipOccupancyMaxActiveBlocksPerMultiprocessor(&per_cu, (const void*)fwd_megakernel, NWAVES * 64, LDS_BYTES) != hipSuccess || per_cu < 1) fprintf(stderr, "kernel_launch: occupancy query reports %d\n", per_cu);
        (void)hipGetLastError();
        grid = cus;
    }
    if (grid < 0) return;
    if (hipMemsetAsync((char*)d_ws + WS_CTL, 0, CTL_ZERO_BYTES, stream) != hipSuccess) { fprintf(stderr, "kernel_launch: memset failed\n"); return; }
    Args a{};
    for (int i = 0; i < 22; ++i) a.in[i] = (const float*)d_in[i];
    a.out = (float*)d_out; a.ws = (unsigned char*)d_ws;
    hipLaunchKernelGGL(fwd_megakernel, dim3(grid), dim3(NWAVES * 64), LDS_BYTES, stream, a);
}
```
